# Optimizing an MI355X kernel written in HIP

```python
import jax, jax.numpy as jnp
from jax import lax
import numpy as np

D_MODEL = 1024
BATCH = 4
SEQ = 4096
DEPTH = 1

POOL_WIDTH = D_MODEL
POOL_GROUPS = 4
POOL_GROUP_DIM = POOL_WIDTH // POOL_GROUPS
POOL_WINDOWS = (2, 4, 8, 16)
MLSTM_WIDTH = D_MODEL
MLSTM_HEADS = 4
MLSTM_HEAD_DIM = MLSTM_WIDTH // MLSTM_HEADS
CONV_WIDTH = 4
CHUNK = 128
D_FF = 4 * D_MODEL
N_BRANCHES = 2
SPLIT_POINTS = (
    POOL_WIDTH,
    POOL_WIDTH + MLSTM_WIDTH,
    POOL_WIDTH + 2 * MLSTM_WIDTH,
    POOL_WIDTH + 3 * MLSTM_WIDTH,
    POOL_WIDTH + 3 * MLSTM_WIDTH + MLSTM_HEADS,
    POOL_WIDTH + 3 * MLSTM_WIDTH + 2 * MLSTM_HEADS,
    POOL_WIDTH + 3 * MLSTM_WIDTH + 2 * MLSTM_HEADS + D_MODEL,
)
IN_WIDTH = POOL_WIDTH + 3 * MLSTM_WIDTH + 2 * MLSTM_HEADS + N_BRANCHES * D_MODEL
DEEPNORM_ALPHA = (2.0 * DEPTH) ** 0.25
DEEPNORM_BETA = (8.0 * DEPTH) ** -0.25
LN_EPS = 1e-5
HEAD_NORM_EPS = 1e-6

kernel_name = 'hybrid_pool_mlstm_deepnorm_block'


def layer_norm(x, g, b):
    x32 = x.astype(jnp.float32)
    mu = jnp.mean(x32, axis=-1, keepdims=True)
    var = jnp.mean(jnp.square(x32 - mu), axis=-1, keepdims=True)
    y = (x32 - mu) * lax.rsqrt(var + LN_EPS) * g.astype(jnp.float32) + b.astype(jnp.float32)
    return y.astype(x.dtype)


def multiscale_causal_pool(u):
    S_ = u.shape[1]
    u32 = u.astype(jnp.float32)
    cs = jnp.concatenate([jnp.zeros_like(u32[:, :1]), jnp.cumsum(u32, axis=1)], axis=1)
    t = jnp.arange(S_)
    outs = []
    for g, w in enumerate(POOL_WINDOWS):
        sl = slice(g * POOL_GROUP_DIM, (g + 1) * POOL_GROUP_DIM)
        csg = cs[:, :, sl]
        upper = csg[:, 1:]
        lower = jnp.pad(csg, ((0, 0), (w - 1, 0), (0, 0)))[:, :S_]
        count = jnp.minimum(t + 1, w).astype(jnp.float32)[None, :, None]
        outs.append((upper - lower) / count - u32[:, :, sl])
    return jnp.stack(outs, axis=2)


def causal_depthwise_conv(x, w, b):
    y = lax.conv_general_dilated(
        x, w[:, None, :].astype(x.dtype), window_strides=(1,), padding=[(CONV_WIDTH - 1, 0)],
        dimension_numbers=('NWC', 'WIO', 'NWC'), feature_group_count=x.shape[-1])
    return y + b.astype(x.dtype)


def mlstm_chunkwise(q, k, v, i_pre, f_pre):
    B_, NH, S_, DH = q.shape
    NC = S_ // CHUNK
    q, k, v = (a.astype(jnp.float32) for a in (q, k, v))
    log_f = jax.nn.log_sigmoid(f_pre.astype(jnp.float32))
    ig = i_pre.astype(jnp.float32)

    def to_chunks(a):
        return jnp.moveaxis(a.reshape(B_, NH, NC, CHUNK, *a.shape[3:]), 2, 0)

    xs = (to_chunks(q), to_chunks(k), to_chunks(v), to_chunks(ig), to_chunks(log_f))
    causal = jnp.tril(jnp.ones((CHUNK, CHUNK), dtype=bool))

    def step(carry, inp):
        C, n, m = carry
        q_, k_, v_, ig_, lf_ = inp
        b = jnp.cumsum(lf_, axis=-1)
        d = jnp.where(causal, b[..., :, None] - b[..., None, :] + ig_[..., None, :], -jnp.inf)
        inter = b + m[..., None]
        m_row = jnp.maximum(inter, jnp.max(d, axis=-1))
        scores = jnp.einsum('bhld,bhsd->bhls', q_, k_) * jnp.exp(d - m_row[..., None])
        w_inter = jnp.exp(inter - m_row)
        num = w_inter[..., None] * jnp.einsum('bhld,bhdv->bhlv', q_, C) + jnp.einsum('bhls,bhsv->bhlv', scores, v_)
        den = w_inter * jnp.einsum('bhld,bhd->bhl', q_, n) + jnp.sum(scores, axis=-1)
        h = num / jnp.maximum(jnp.abs(den), jnp.exp(-m_row))[..., None]
        b_last = b[..., -1]
        tail = b_last[..., None] - b + ig_
        m_new = jnp.maximum(b_last + m, jnp.max(tail, axis=-1))
        w_state = jnp.exp(tail - m_new[..., None])
        decay = jnp.exp(b_last + m - m_new)
        C_new = decay[..., None, None] * C + jnp.einsum('bhs,bhsd,bhsv->bhdv', w_state, k_, v_)
        n_new = decay[..., None] * n + jnp.einsum('bhs,bhsd->bhd', w_state, k_)
        return (C_new, n_new, m_new), h

    init = (jnp.zeros((B_, NH, DH, DH), jnp.float32), jnp.zeros((B_, NH, DH), jnp.float32),
            jnp.zeros((B_, NH), jnp.float32))
    _, hs = lax.scan(step, init, xs)
    return jnp.moveaxis(hs, 0, 2).reshape(B_, NH, S_, DH)


def head_layer_norm(h, g):
    mu = jnp.mean(h, axis=-1, keepdims=True)
    var = jnp.mean(jnp.square(h - mu), axis=-1, keepdims=True)
    return (h - mu) * lax.rsqrt(var + HEAD_NORM_EPS) * g.astype(jnp.float32)[None, :, None, :]


def setup_inputs(seed: int = 0) -> dict:
    key = jax.random.key(seed)
    ks = jax.random.split(key, 24)
    nrm = jax.random.normal
    L, D, P, E, NH, DH = DEPTH, D_MODEL, POOL_WIDTH, MLSTM_WIDTH, MLSTM_HEADS, MLSTM_HEAD_DIM
    G, C = POOL_GROUPS, POOL_GROUP_DIM
    f32 = jnp.float32
    return {
        'x': nrm(ks[0], (BATCH, SEQ, D), f32),
        'w_in': nrm(ks[1], (L, D, IN_WIDTH), f32) * D ** -0.5,
        'conv_w': nrm(ks[2], (L, CONV_WIDTH, E), f32) * CONV_WIDTH ** -0.5,
        'conv_b': nrm(ks[3], (L, E), f32) * 0.02,
        'w_q': nrm(ks[4], (L, NH, DH, DH), f32) * DH ** -0.5,
        'w_k': nrm(ks[5], (L, NH, DH, DH), f32) * DH ** -0.5,
        'b_igate': nrm(ks[6], (L, NH), f32) * 0.1,
        'b_fgate': jnp.linspace(3.0, 6.0, NH, dtype=f32)[None, :] + nrm(ks[7], (L, NH), f32) * 0.1,
        'head_norm_g': 1.0 + nrm(ks[8], (L, NH, DH), f32) * 0.02,
        'pool_w': nrm(ks[9], (L, G, C, C), f32) * C ** -0.5,
        'pool_scale': 1.0 + nrm(ks[10], (L, P), f32) * 0.02,
        'w_pool_proj': nrm(ks[11], (L, P, D), f32) * P ** -0.5,
        'w_mlstm_proj': nrm(ks[12], (L, E, D), f32) * E ** -0.5,
        'w_out': nrm(ks[13], (L, D, D), f32) * (D ** -0.5 * DEEPNORM_BETA),
        'ln1_g': 1.0 + nrm(ks[14], (L, D), f32) * 0.02,
        'ln1_b': nrm(ks[15], (L, D), f32) * 0.02,
        'w_up': nrm(ks[16], (L, D, D_FF), f32) * D ** -0.5,
        'w_down': nrm(ks[17], (L, D_FF, D), f32) * (D_FF ** -0.5 * DEEPNORM_BETA),
        'ln2_g': 1.0 + nrm(ks[18], (L, D), f32) * 0.02,
        'ln2_b': nrm(ks[19], (L, D), f32) * 0.02,
    }


def reference(x, w_in, conv_w, conv_b, w_q, w_k, b_igate, b_fgate, head_norm_g, pool_w, pool_scale,
              w_pool_proj, w_mlstm_proj, w_out, ln1_g, ln1_b, w_up, w_down, ln2_g, ln2_b):
    B_, S_, D = x.shape
    NH, DH = MLSTM_HEADS, MLSTM_HEAD_DIM
    for l in range(DEPTH):
        proj = jnp.einsum('bsd,de->bse', x, w_in[l])
        u, xm, v, o_pre, i_pre, f_pre, g_pool, g_mlstm = jnp.split(proj, SPLIT_POINTS, axis=-1)

        pooled = multiscale_causal_pool(u)
        pooled = jnp.einsum('bsgc,gce->bsge', pooled.astype(x.dtype), pool_w[l])
        pooled = pooled.reshape(B_, S_, POOL_WIDTH) * pool_scale[l]
        pool_out = jnp.einsum('bsp,pd->bsd', pooled, w_pool_proj[l])

        xc = jax.nn.silu(causal_depthwise_conv(xm, conv_w[l], conv_b[l]))
        xc_h = xc.reshape(B_, S_, NH, DH)
        q = jnp.einsum('bshd,hde->bhse', xc_h, w_q[l])
        k = jnp.einsum('bshd,hde->bhse', xc_h, w_k[l]) * (DH ** -0.5)
        vh = v.reshape(B_, S_, NH, DH).transpose(0, 2, 1, 3)
        ig = (i_pre + b_igate[l]).transpose(0, 2, 1)
        fg = (f_pre + b_fgate[l]).transpose(0, 2, 1)
        h = head_layer_norm(mlstm_chunkwise(q, k, vh, ig, fg), head_norm_g[l])
        h = h.transpose(0, 2, 1, 3).reshape(B_, S_, MLSTM_WIDTH).astype(x.dtype) * jax.nn.sigmoid(o_pre)
        mlstm_out = jnp.einsum('bse,ed->bsd', h, w_mlstm_proj[l])

        merged = jax.nn.sigmoid(g_pool) * pool_out + jax.nn.sigmoid(g_mlstm) * mlstm_out
        mix = jnp.einsum('bsd,de->bse', merged, w_out[l])
        x = layer_norm(DEEPNORM_ALPHA * x + mix, ln1_g[l], ln1_b[l])

        hid = jnp.square(jax.nn.relu(jnp.einsum('bsd,df->bsf', x, w_up[l])))
        x = layer_norm(DEEPNORM_ALPHA * x + jnp.einsum('bsf,fd->bsd', hid, w_down[l]), ln2_g[l], ln2_b[l])
    return x
```

```cpp
#include <hip/hip_runtime.h>
#include <hip/hip_cooperative_groups.h>
#include <cstdio>
#include <cstdint>
namespace cg = cooperative_groups;

namespace pg8 {
#define PG8_LAS __attribute__((address_space(3)))
typedef unsigned short bf16_t;
typedef short bf16x8 __attribute__((ext_vector_type(8)));
typedef float f32x4 __attribute__((ext_vector_type(4)));
typedef unsigned u32x4 __attribute__((ext_vector_type(4)));
constexpr int BM = 256, BK = 64, HALF = 128, HTB = HALF * BK * 2  , STAGE_BYTES = 8 * HTB;

__host__ __device__ __forceinline__ int lds_byte(int r, int c) { const int st = (r >> 4) * 2 + (c >> 5), rr = r & 15, cc = c & 31, ob = rr * 64 + cc * 2; return st * 1024 + (ob ^ (((ob >> 9) & 1) << 5)); }
__host__ __device__ __forceinline__ void stage_rc(int b, int& R, int& C) { const int st = b / 1024, sb = b % 1024, swz = sb ^ (((sb >> 9) & 1) << 5); R = (st >> 1) * 16 + swz / 64; C = (st & 1) * 32 + (swz % 64) / 2; }
__host__ __device__ __forceinline__ int perm32(int rho) { const int n = rho >> 4, i = rho & 15; return 8 * (i >> 2) + 4 * n + (i & 3); }

struct Unit { int pm, pn, kind; const char* a; const char* b; };

__device__ __forceinline__ void tmpl_decode(int wgid, int nM, int nN, int& pm, int& pn) {
    const int nwg = nM * nN;
    { const int q = nwg / 8, r = nwg % 8, xcd = wgid % 8, off = wgid / 8; wgid = (xcd < r ? xcd * (q + 1) : r * (q + 1) + (xcd - r) * q) + off; }
    const int nig = 8 * nN, gid = wgid / nig, fm = gid * 8, gsz = (nM - fm) < 8 ? (nM - fm) : 8;
    pm = fm + ((wgid % nig) % gsz); pn = (wgid % nig) / gsz;
}

template <class Epi, class Sched, bool ALIGN_EPI = true, bool SP2 = true>
__device__ __forceinline__ void gemm_phase(PG8_LAS unsigned char* lds, const int K, const int lda, const int ldb, const Sched& S, const Epi& E) {
    int tid_ = threadIdx.x; asm volatile("" : "+v"(tid_));
    const int tid = tid_, wid = __builtin_amdgcn_readfirstlane(tid >> 6), lane = tid & 63, wr = wid >> 2, wc = wid & 3, fr = lane & 15, fq = lane >> 4;
    int nt = K / BK; asm volatile("" : "+s"(nt));
    unsigned voffA[2], voffB[2];
#pragma unroll
    for (int i = 0; i < 2; ++i) { int R, C; stage_rc(tid * 16 + i * 8192, R, C); const int Rb = Epi::PERM ? ((R & ~31) + perm32(R & 31)) : R;
        voffA[i] = (unsigned)(R * lda + C) * 2u; voffB[i] = (unsigned)(Rb * ldb + C) * 2u; }
    const size_t kstep = (size_t)(BK * 2);
    const size_t hstepA = (size_t)HALF * lda * 2, hstepB = (size_t)HALF * ldb * 2;
    const unsigned ldsw = (unsigned)wid * 1024u;
    const int aoff = lds_byte(wr * 64 + fr, fq * 8), boff = lds_byte(wc * 32 + fr, fq * 8);
#define PG8_SA(b, h) (((b) * 2 + (h)) * HTB)
#define PG8_SB(b, h) ((4 + (b) * 2 + (h)) * HTB)
#define PG8_STAGE(bufoff, gbase, voff) do { _Pragma("unroll") for (int _i = 0; _i < 2; ++_i) \
        __builtin_amdgcn_global_load_lds((const unsigned*)((const char*)(gbase) + (voff)[_i]), (PG8_LAS unsigned*)(lds + (bufoff) + ldsw + _i * 8192), 16, 0, 0); } while (0)
#define PG8_LDA(dst, b, h) do { _Pragma("unroll") for (int m = 0; m < 4; ++m) _Pragma("unroll") for (int k = 0; k < 2; ++k) dst[m][k] = *(const PG8_LAS bf16x8*)(lds + PG8_SA(b, h) + aoff + m * 2048 + k * 1024); } while (0)
#define PG8_LDB(dst, b, h) do { _Pragma("unroll") for (int n = 0; n < 2; ++n) _Pragma("unroll") for (int k = 0; k < 2; ++k) dst[n][k] = *(const PG8_LAS bf16x8*)(lds + PG8_SB(b, h) + boff + n * 2048 + k * 1024); } while (0)
#define PG8_MMA(ai, bj, At, Bt) do { __builtin_amdgcn_s_setprio(1); _Pragma("unroll") for (int m = 0; m < 4; ++m) _Pragma("unroll") for (int n = 0; n < 2; ++n) _Pragma("unroll") for (int k = 0; k < 2; ++k) \
        acc[ai][bj][m][n] = __builtin_amdgcn_mfma_f32_16x16x32_bf16(Bt[n][k], At[m][k], acc[ai][bj][m][n], 0, 0, 0); __builtin_amdgcn_s_setprio(0); } while (0)
#define PG8_WAIT_V(n) asm volatile("s_waitcnt vmcnt(" #n ")" ::: "memory")
#define PG8_WAIT_L(n) asm volatile("s_waitcnt lgkmcnt(" #n ")" ::: "memory")
#define PG8_BAR __builtin_amdgcn_s_barrier()
#define PG8_SCHED __builtin_amdgcn_sched_barrier(0)
    Unit cur, nxt; int ui = 0;
    if (!S.next(0, cur)) return;
    f32x4 acc[2][2][4][2];
#pragma unroll
    for (int a = 0; a < 2; ++a)
#pragma unroll
        for (int b = 0; b < 2; ++b)
#pragma unroll
            for (int m = 0; m < 4; ++m)
#pragma unroll
                for (int n = 0; n < 2; ++n) acc[a][b][m][n] = (f32x4){0.f, 0.f, 0.f, 0.f};
    bf16x8 At[4][2], B0[2][2], B1[2][2];
    const char* cA = cur.a; const char* cB = cur.b;
    if constexpr (SP2) {
        PG8_STAGE(PG8_SB(0, 0), cB, voffB); PG8_STAGE(PG8_SB(0, 1), cB + hstepB, voffB); PG8_STAGE(PG8_SA(0, 0), cA, voffA); PG8_STAGE(PG8_SA(0, 1), cA + hstepA, voffA);
        if (wr == 1) PG8_BAR;
        PG8_WAIT_V(2); PG8_BAR;
        PG8_STAGE(PG8_SB(1, 0), cB + kstep, voffB); PG8_STAGE(PG8_SA(1, 0), cA + kstep, voffA); PG8_STAGE(PG8_SB(1, 1), cB + hstepB + kstep, voffB);
        PG8_WAIT_V(6); PG8_BAR;
    } else {
        PG8_STAGE(PG8_SB(0, 0), cB, voffB); PG8_STAGE(PG8_SA(0, 0), cA, voffA); PG8_STAGE(PG8_SB(0, 1), cB + hstepB, voffB); PG8_STAGE(PG8_SA(0, 1), cA + hstepA, voffA);
        if (wr == 1) PG8_BAR;
        PG8_WAIT_V(4); PG8_BAR;
        PG8_STAGE(PG8_SB(1, 0), cB + kstep, voffB); PG8_STAGE(PG8_SA(1, 0), cA + kstep, voffA); PG8_STAGE(PG8_SB(1, 1), cB + hstepB + kstep, voffB);
        PG8_WAIT_V(6); PG8_BAR;
    }
    for (;;) {
        const bool has_next = S.next(ui + 1, nxt);
        const char* nA = has_next ? nxt.a : cA; const char* nB = has_next ? nxt.b : cB;
#pragma nounroll
        for (int t = 0; t < nt; t += 2) {
            const bool last = (t == nt - 2);
            const char* a1 = cA + (size_t)(t + 1) * kstep;
            const char* a2 = last ? nA : cA + (size_t)(t + 2) * kstep; const char* b2 = last ? nB : cB + (size_t)(t + 2) * kstep;
            const char* a3 = a2 + kstep; const char* b3 = b2 + kstep;
            if constexpr (SP2) {
            PG8_LDB(B0, 0, 0); PG8_LDB(B1, 0, 1); PG8_SCHED; PG8_LDA(At, 0, 0); PG8_STAGE(PG8_SA(1, 1), a1 + hstepA, voffA);
            PG8_WAIT_V(8); PG8_WAIT_L(0); PG8_BAR; PG8_MMA(0, 0, At, B0); PG8_MMA(0, 1, At, B1); PG8_BAR; PG8_SCHED;
            PG8_LDA(At, 0, 1); PG8_STAGE(PG8_SB(0, 0), b2, voffB); PG8_STAGE(PG8_SB(0, 1), b2 + hstepB, voffB); PG8_STAGE(PG8_SA(0, 0), a2, voffA);
            PG8_WAIT_V(8); PG8_WAIT_L(0); PG8_BAR; PG8_MMA(1, 0, At, B0); PG8_MMA(1, 1, At, B1); PG8_BAR; PG8_SCHED;
            PG8_LDB(B0, 1, 0); PG8_LDB(B1, 1, 1); PG8_SCHED; PG8_LDA(At, 1, 0); PG8_STAGE(PG8_SA(0, 1), a2 + hstepA, voffA);
            PG8_WAIT_V(8); PG8_WAIT_L(0); PG8_BAR; PG8_MMA(0, 0, At, B0); PG8_MMA(0, 1, At, B1); PG8_BAR; PG8_SCHED;
            PG8_LDA(At, 1, 1); PG8_STAGE(PG8_SB(1, 0), b3, voffB); PG8_STAGE(PG8_SB(1, 1), b3 + hstepB, voffB); PG8_STAGE(PG8_SA(1, 0), a3, voffA);
            PG8_WAIT_V(8); PG8_WAIT_L(0); PG8_BAR; PG8_MMA(1, 0, At, B0); PG8_MMA(1, 1, At, B1); PG8_BAR; PG8_SCHED;
            } else {
            PG8_LDB(B0, 0, 0); PG8_SCHED; PG8_LDA(At, 0, 0); PG8_STAGE(PG8_SA(1, 1), a1 + hstepA, voffA);
            PG8_WAIT_L(8); PG8_BAR; PG8_WAIT_L(0); PG8_MMA(0, 0, At, B0); PG8_BAR; PG8_SCHED;
            PG8_LDB(B1, 0, 1); PG8_STAGE(PG8_SB(0, 0), b2, voffB);
            PG8_BAR; PG8_WAIT_L(0); PG8_MMA(0, 1, At, B1); PG8_BAR;
            PG8_LDA(At, 0, 1); PG8_STAGE(PG8_SA(0, 0), a2, voffA);
            PG8_BAR; PG8_WAIT_L(0); PG8_MMA(1, 0, At, B0); PG8_BAR; PG8_SCHED;
            PG8_STAGE(PG8_SB(0, 1), b2 + hstepB, voffB);
            PG8_WAIT_V(6); PG8_BAR; PG8_MMA(1, 1, At, B1); PG8_BAR;
            PG8_LDB(B0, 1, 0); PG8_SCHED; PG8_LDA(At, 1, 0); PG8_STAGE(PG8_SA(0, 1), a2 + hstepA, voffA);
            PG8_WAIT_L(8); PG8_BAR; PG8_WAIT_L(0); PG8_MMA(0, 0, At, B0); PG8_BAR; PG8_SCHED;
            PG8_LDB(B1, 1, 1); PG8_STAGE(PG8_SB(1, 0), b3, voffB);
            PG8_BAR; PG8_WAIT_L(0); PG8_MMA(0, 1, At, B1); PG8_BAR;
            PG8_LDA(At, 1, 1); PG8_STAGE(PG8_SA(1, 0), a3, voffA);
            PG8_BAR; PG8_WAIT_L(0); PG8_MMA(1, 0, At, B0); PG8_BAR; PG8_SCHED;
            PG8_STAGE(PG8_SB(1, 1), b3 + hstepB, voffB);
            PG8_WAIT_V(6); PG8_BAR; PG8_MMA(1, 1, At, B1); PG8_BAR;
            }
        }
        if constexpr (ALIGN_EPI) { if (wr == 0) PG8_BAR; }
        if constexpr (!Epi::AFTER_DRAIN) { E(acc, cur, wr, wc, fr, fq); }
        if (!has_next) break;
#pragma unroll
        for (int a = 0; a < 2; ++a)
#pragma unroll
            for (int b = 0; b < 2; ++b)
#pragma unroll
                for (int m = 0; m < 4; ++m)
#pragma unroll
                    for (int n = 0; n < 2; ++n) acc[a][b][m][n] = (f32x4){0.f, 0.f, 0.f, 0.f};
        cur = nxt; cA = nA; cB = nB; ++ui;
        if constexpr (ALIGN_EPI) { if (wr == 1) PG8_BAR; }
    }
    PG8_WAIT_V(0);
    if constexpr (!ALIGN_EPI) { if (wr == 0) PG8_BAR; }
    PG8_BAR;
#undef PG8_SA
#undef PG8_SB
#undef PG8_STAGE
#undef PG8_LDA
#undef PG8_LDB
#undef PG8_MMA
#undef PG8_WAIT_V
#undef PG8_WAIT_L
#undef PG8_BAR
#undef PG8_SCHED
}
}

using pg8::Unit; using pg8::bf16_t; using pg8::f32x4; using pg8::u32x4; using pg8::tmpl_decode;
#define LAS __attribute__((address_space(3)))
typedef unsigned u32x2 __attribute__((ext_vector_type(2)));
#define LDS_WAIT() asm volatile("s_waitcnt lgkmcnt(0)" ::: "memory")

constexpr int T = 16384, DM = 1024, SEQ = 4096, FF = 4096, INW = 6152;
constexpr float ALPHA = 1.18920711500272f;
constexpr float LN_EPS = 1e-5f, HN_EPS = 1e-6f;
constexpr size_t MiB = 1u << 20;
constexpr size_t W_CAT = 0, W_G = 6 * MiB, W_VT = 10 * MiB, W_PP = 12 * MiB, W_M = 14 * MiB, W_O = 16 * MiB, W_PW = 18 * MiB, W_Q = 18 * MiB + 512 * 1024, W_K = 19 * MiB;
constexpr size_t W_UP = 0, W_DN = 8 * MiB;
constexpr size_t S_IG = 24 * MiB, S_LF = S_IG + 256 * 1024, S_WS = S_LF + 256 * 1024, S_EB = S_WS + 256 * 1024, S_DNP = 25 * MiB, S_DN = S_DNP + 256 * 1024, S_KAP = S_DN + 256 * 1024;
constexpr size_t SLOT0 = 32 * MiB, SLOT = 32 * MiB;
constexpr size_t WS_NEED = 256 * MiB;

__device__ __forceinline__ unsigned cvt_pk_bf16(float lo, float hi) { unsigned r; asm("v_cvt_pk_bf16_f32 %0, %1, %2" : "=v"(r) : "v"(lo), "v"(hi)); return r; }
__device__ __forceinline__ float bf_lo(unsigned w) { return __uint_as_float(w << 16); }
__device__ __forceinline__ float bf_hi(unsigned w) { return __uint_as_float(w & 0xffff0000u); }
__device__ __forceinline__ u32x4 pack8(f32x4 a, f32x4 b) { u32x4 w; w.x = cvt_pk_bf16(a[0], a[1]); w.y = cvt_pk_bf16(a[2], a[3]); w.z = cvt_pk_bf16(b[0], b[1]); w.w = cvt_pk_bf16(b[2], b[3]); return w; }
__device__ __forceinline__ void unpack8(u32x4 w, f32x4& a, f32x4& b) { a[0] = bf_lo(w.x); a[1] = bf_hi(w.x); a[2] = bf_lo(w.y); a[3] = bf_hi(w.y); b[0] = bf_lo(w.z); b[1] = bf_hi(w.z); b[2] = bf_lo(w.w); b[3] = bf_hi(w.w); }
__device__ __forceinline__ float sigm(float x) { return __builtin_amdgcn_rcpf(1.f + __expf(-x)); }
__device__ __forceinline__ f32x4 sigm4(f32x4 v) { f32x4 r; r[0] = sigm(v[0]); r[1] = sigm(v[1]); r[2] = sigm(v[2]); r[3] = sigm(v[3]); return r; }
__device__ __forceinline__ float wave_sum(float v) {
#pragma unroll
    for (int o = 1; o < 64; o <<= 1) v += __shfl_xor(v, o);
    return v;
}
__device__ __forceinline__ float wave_max(float v) {
#pragma unroll
    for (int o = 1; o < 64; o <<= 1) v = fmaxf(v, __shfl_xor(v, o));
    return v;
}

#define EPI_HEAD static constexpr bool PERM = true, AFTER_DRAIN = false;
#define EPI_SIG (const f32x4 (&acc)[2][2][4][2], const Unit& u, int wr, int wc, int fr, int fq) const
#define EPI_FOR_ROWS _Pragma("unroll") for (int ai = 0; ai < 2; ++ai) _Pragma("unroll") for (int m = 0; m < 4; ++m)
#define EPI_FOR_COLS _Pragma("unroll") for (int bj = 0; bj < 2; ++bj)
#define EPI_LROW (ai * 128 + wr * 64 + m * 16 + fr)
#define EPI_LCOL (bj * 128 + wc * 32 + 8 * fq)

struct SchedMN { const char *A, *B; int nM, nN, nU, G, c; size_t sa, apn, sb, bpm;
    __device__ __forceinline__ bool next(int i, Unit& u) const { const int L = i * G + c; if (L >= nU) return false;
        tmpl_decode(L, nM, nN, u.pm, u.pn); u.kind = 0; u.a = A + (size_t)u.pm * sa + (size_t)u.pn * apn; u.b = B + (size_t)u.pn * sb + (size_t)u.pm * bpm; return true; } };
template <int SIGSEC> struct EpiSec { EPI_HEAD bf16_t* base; size_t secstride;
    __device__ __forceinline__ void operator() EPI_SIG {
        const int sec = u.pn >> 2; bf16_t* bp = base + (size_t)sec * secstride + (u.pn & 3) * 256;
        EPI_FOR_ROWS { const int row = u.pm * 256 + EPI_LROW;
            EPI_FOR_COLS { f32x4 v0 = acc[ai][bj][m][0], v1 = acc[ai][bj][m][1];
                if (sec >= SIGSEC) { v0 = sigm4(v0); v1 = sigm4(v1); }
                *(u32x4*)(bp + (size_t)row * 1024 + EPI_LCOL) = pack8(v0, v1); } } } };
template <int WEIGHT> struct EpiT { EPI_HEAD bf16_t* DST; const float* WS;
    __device__ __forceinline__ void operator() EPI_SIG {
        EPI_FOR_ROWS { const int rowl = u.pm * 256 + EPI_LROW;
            EPI_FOR_COLS { const int tok = u.pn * 256 + EPI_LCOL, b_ = tok >> 12, s = tok & 4095; f32x4 v0 = acc[ai][bj][m][0], v1 = acc[ai][bj][m][1];
                if (WEIGHT) { const float* wp = WS + (size_t)(b_ * 4 + u.pm) * 4096 + s; v0 = v0 * *(const f32x4*)wp; v1 = v1 * *(const f32x4*)(wp + 4); }
                *(u32x4*)(DST + ((size_t)(b_ * 1024 + rowl)) * 4096 + s) = pack8(v0, v1); } } } };
template <int MODE> struct EpiScale { EPI_HEAD bf16_t* DST; const float* sc;
    __device__ __forceinline__ void operator() EPI_SIG {
        EPI_FOR_ROWS { const int row = u.pm * 256 + EPI_LROW; float rs = 1.f;
            if (MODE == 1) rs = sc[(size_t)((row >> 12) * 4 + u.pn) * 4096 + (row & 4095)];
            EPI_FOR_COLS { const int col = u.pn * 256 + EPI_LCOL; f32x4 v0 = acc[ai][bj][m][0], v1 = acc[ai][bj][m][1];
                if (MODE == 0) { v0 = v0 * *(const f32x4*)(sc + col); v1 = v1 * *(const f32x4*)(sc + col + 4); }
                else { v0 = v0 * rs; v1 = v1 * rs; }
                *(u32x4*)(DST + (size_t)row * 1024 + col) = pack8(v0, v1); } } } };
struct Sched4 { const char *VT, *KT; int G, c;
    __device__ __forceinline__ bool next(int i, Unit& u) const { const int L = i * G + c; if (L >= 256) return false;
        u.pm = L; u.pn = 0; u.kind = 0; const size_t off = ((size_t)(L >> 4) * 256 * 4096 + (size_t)(L & 15) * 256) * 2; u.a = VT + off; u.b = KT + off; return true; } };
struct Epi4 { EPI_HEAD float* DC;
    __device__ __forceinline__ void operator() EPI_SIG {
        EPI_FOR_ROWS { float* rp = DC + ((size_t)u.pm * 256 + EPI_LROW) * 256;
            EPI_FOR_COLS { *(f32x4*)(rp + EPI_LCOL) = acc[ai][bj][m][0]; *(f32x4*)(rp + EPI_LCOL + 4) = acc[ai][bj][m][1]; } } } };
struct Sched5 { const char *Q, *KW; int G, c;
    __device__ __forceinline__ bool next(int i, Unit& u) const { const int L = i * G + c; if (L >= 256) return false;
        u.pm = L; u.pn = 0; u.kind = 0; const int bh = L >> 4, ch = L & 15; const size_t off = ((size_t)((bh >> 2) * 4096 + ch * 256) * 1024 + (size_t)(bh & 3) * 256) * 2; u.a = Q + off; u.b = KW + off; return true; } };
struct Epi5 { EPI_HEAD bf16_t* P;
    __device__ __forceinline__ void operator() EPI_SIG {
        asm volatile("" : "+v"(fr));
        EPI_FOR_ROWS { const int i = EPI_LROW; bf16_t* rp = P + ((size_t)u.pm * 256 + i) * 256;
            EPI_FOR_COLS { const int j0 = EPI_LCOL; f32x4 v0 = acc[ai][bj][m][0], v1 = acc[ai][bj][m][1];
#pragma unroll
                for (int e = 0; e < 4; ++e) { const int lim = i - j0; v0[e] = (lim >= e) ? v0[e] : 0.f; v1[e] = (lim >= e + 4) ? v1[e] : 0.f; }
                *(u32x4*)(rp + j0) = pack8(v0, v1); __builtin_amdgcn_sched_barrier(0); } } } };
template <int MODE> struct Sched6 { const char *A, *B; int G, c;
    __device__ __forceinline__ bool next(int i, Unit& u) const { const int L = i * G + c; if (L >= 256) return false;
        const int bh = L >> 4, ch = L & 15; u.pm = (bh >> 2) * 16 + ch; u.pn = bh & 3; u.kind = 0;
        if (MODE == 0) { u.a = A + ((size_t)((bh >> 2) * 4096 + ch * 256) * 1024 + (size_t)(bh & 3) * 256) * 2; u.b = B + (size_t)L * 256 * 1024; }
        else { u.a = A + (size_t)L * 65536 * 2; u.b = B + ((size_t)bh * 256 * 4096 + (size_t)ch * 256) * 2; }
        return true; } };
template <int ADD> struct Epi6 { EPI_HEAD bf16_t* OUTP;
    __device__ __forceinline__ void operator() EPI_SIG {
        EPI_FOR_ROWS { const int row = u.pm * 256 + EPI_LROW;
            EPI_FOR_COLS { const int col = u.pn * 256 + EPI_LCOL; f32x4 v0 = acc[ai][bj][m][0], v1 = acc[ai][bj][m][1]; u32x4* p = (u32x4*)(OUTP + (size_t)row * 1024 + col);
                if (ADD) { f32x4 o0, o1; unpack8(*p, o0, o1); v0 = v0 + o0; v1 = v1 + o1; }
                *p = pack8(v0, v1); } } } };
struct Epi9 { EPI_HEAD const bf16_t *PO, *SGP, *SGM; bf16_t* MG;
    __device__ __forceinline__ void operator() EPI_SIG {
        EPI_FOR_ROWS { const int row = u.pm * 256 + EPI_LROW;
            EPI_FOR_COLS { const size_t o = (size_t)row * 1024 + u.pn * 256 + EPI_LCOL; f32x4 p0, p1, g0, g1, h0, h1;
                unpack8(*(const u32x4*)(PO + o), p0, p1); unpack8(*(const u32x4*)(SGP + o), g0, g1); unpack8(*(const u32x4*)(SGM + o), h0, h1);
                *(u32x4*)(MG + o) = pack8(g0 * p0 + h0 * acc[ai][bj][m][0], g1 * p1 + h1 * acc[ai][bj][m][1]); } } } };
struct EpiRes { EPI_HEAD const float* R; float* Y;
    __device__ __forceinline__ void operator() EPI_SIG {
        EPI_FOR_ROWS { const int row = u.pm * 256 + EPI_LROW;
            EPI_FOR_COLS { const size_t o = (size_t)row * 1024 + u.pn * 256 + EPI_LCOL;
                *(f32x4*)(Y + o) = *(const f32x4*)(R + o) * ALPHA + acc[ai][bj][m][0]; *(f32x4*)(Y + o + 4) = *(const f32x4*)(R + o + 4) * ALPHA + acc[ai][bj][m][1]; } } } };
struct EpiUp { EPI_HEAD bf16_t* HID;
    __device__ __forceinline__ void operator() EPI_SIG {
        EPI_FOR_ROWS { const int row = u.pm * 256 + EPI_LROW;
            EPI_FOR_COLS { const size_t o = (size_t)row * 4096 + u.pn * 256 + EPI_LCOL; f32x4 v0 = acc[ai][bj][m][0], v1 = acc[ai][bj][m][1];
#pragma unroll
                for (int e = 0; e < 4; ++e) { const float a = fmaxf(v0[e], 0.f), b = fmaxf(v1[e], 0.f); v0[e] = a * a; v1[e] = b * b; }
                *(u32x4*)(HID + o) = pack8(v0, v1); } } } };

struct Ctx { LAS unsigned char* lds; int tid, lane, wave, gw, ngw, gtid, ngt; };

__device__ __forceinline__ void transpose_item(const float* src, int ld, int K, bf16_t* dst, int kb, int nb, LAS float* scr, int lane, float scale) {
    const int k0 = 64 * kb, n0 = 32 * nb;
#pragma unroll 8
    for (int i = 0; i < 32; ++i) { const int kk = 2 * i + (lane >> 5); scr[kk * 33 + (lane & 31)] = src[(size_t)(k0 + kk) * ld + n0 + (lane & 31)] * scale; }
    LDS_WAIT(); asm volatile("" ::: "memory");
    const int c = lane & 7;
#pragma unroll
    for (int j = 0; j < 4; ++j) { const int n = (lane >> 3) + 8 * j; const LAS float* s = scr + (8 * c) * 33 + n;
        u32x4 o; o.x = cvt_pk_bf16(s[0 * 33], s[1 * 33]); o.y = cvt_pk_bf16(s[2 * 33], s[3 * 33]); o.z = cvt_pk_bf16(s[4 * 33], s[5 * 33]); o.w = cvt_pk_bf16(s[6 * 33], s[7 * 33]);
        *(u32x4*)(dst + (size_t)(n0 + n) * K + k0 + 8 * c) = o; }
    LDS_WAIT(); asm volatile("" ::: "memory");
}
#define TR(SRC, LD, KK, NN, DST, SCALE) { const int nblk = (NN) / 32, nit = ((KK) / 64) * nblk; if (r < nit) { transpose_item(SRC, LD, KK, DST, r / nblk, r % nblk, scr, C.lane, SCALE); continue; } r -= nit; }
#define TR4(SRC, DST, SCALE) { if (r < 128) { const int g = r >> 5, rr = r & 31; transpose_item((SRC) + g * 65536, 256, 256, (DST) + g * 65536, rr >> 3, rr & 7, scr, C.lane, SCALE); continue; } r -= 128; }

__device__ __forceinline__ float log_sigmoid(float z) { return z < 0.f ? z - log1pf(expf(z)) : -log1pf(expf(-z)); }

struct Params { const float* in[20]; float* out; unsigned char* ws; };

__device__ __forceinline__ void phase0(const Ctx& C, const Params& p) {
    unsigned char* ws = p.ws; const float* w_in = p.in[1];
    LAS float* GWT = (LAS float*)C.lds;
    LAS float* scr = (LAS float*)(C.lds + 32768 + C.wave * 8448);
    for (int idx = C.tid; idx < 8192; idx += 512) { const int g = idx >> 10, k = idx & 1023; GWT[idx] = w_in[(size_t)k * INW + 4096 + g]; }
    __syncthreads();
    const float* x = p.in[0]; bf16_t* XB = (bf16_t*)(ws + SLOT0); float* IG = (float*)(ws + S_IG); float* LF = (float*)(ws + S_LF);
    for (int row = C.gw; row < T; row += C.ngw) {
        const f32x4* xr = (const f32x4*)(x + (size_t)row * 1024) + C.lane; f32x4 v[4]; float a8[8];
#pragma unroll
        for (int j = 0; j < 4; ++j) v[j] = xr[64 * j];
#pragma unroll
        for (int g = 0; g < 8; ++g) { float s = 0.f;
#pragma unroll
            for (int j = 0; j < 4; ++j) { const f32x4 w = *(const LAS f32x4*)(GWT + g * 1024 + 4 * (C.lane + 64 * j)); s += (v[j][0] * w[0] + v[j][1] * w[1]) + (v[j][2] * w[2] + v[j][3] * w[3]); }
            a8[g] = wave_sum(s); }
        u32x2* o8 = (u32x2*)(XB + (size_t)row * 1024) + C.lane;
#pragma unroll
        for (int j = 0; j < 4; ++j) { u32x2 w; w.x = cvt_pk_bf16(v[j][0], v[j][1]); w.y = cvt_pk_bf16(v[j][2], v[j][3]); o8[64 * j] = w; }
        if (C.lane == 0) {
#pragma unroll
            for (int h = 0; h < 4; ++h) { IG[(size_t)row * 4 + h] = a8[h] + p.in[6][h]; LF[(size_t)row * 4 + h] = log_sigmoid(a8[4 + h] + p.in[7][h]); } }
    }
    bf16_t* WCAT = (bf16_t*)(ws + W_CAT); bf16_t* WG = (bf16_t*)(ws + W_G);
    constexpr int NITEMS = 6 * 512 + 3 * 128 + 3 * 512;
    for (int it = C.gw; it < NITEMS; it += C.ngw) { int r = it;
        TR(w_in + 0, INW, 1024, 1024, WCAT, 1.f)
        TR(w_in + 1024, INW, 1024, 1024, WCAT + 1024 * 1024, 1.f)
        TR(w_in + 3072, INW, 1024, 1024, WCAT + 2 * 1024 * 1024, 1.f)
        TR(w_in + 2048, INW, 1024, 1024, (bf16_t*)(ws + W_VT), 1.f)
        TR(w_in + 4104, INW, 1024, 1024, WG, 1.f)
        TR(w_in + 5128, INW, 1024, 1024, WG + 1024 * 1024, 1.f)
        TR4(p.in[9], (bf16_t*)(ws + W_PW), 1.f)
        TR4(p.in[4], (bf16_t*)(ws + W_Q), 1.f)
        TR4(p.in[5], (bf16_t*)(ws + W_K), 0.0625f)
        TR(p.in[11], 1024, 1024, 1024, (bf16_t*)(ws + W_PP), 1.f)
        TR(p.in[12], 1024, 1024, 1024, (bf16_t*)(ws + W_M), 1.f)
        TR(p.in[13], 1024, 1024, 1024, (bf16_t*)(ws + W_O), 1.f)
    }
}
__device__ __forceinline__ void late_weights(const Ctx& C, const Params& p) {
    LAS float* scr = (LAS float*)(C.lds + 32768 + C.wave * 8448);
    constexpr int NITEMS = 2 * 2048;
    for (int it = C.gw; it < NITEMS; it += C.ngw) { int r = it;
        TR(p.in[16], 4096, 1024, 4096, (bf16_t*)(p.ws + W_UP), 1.f)
        TR(p.in[17], 1024, 4096, 1024, (bf16_t*)(p.ws + W_DN), 1.f)
    }
}

__device__ __forceinline__ void phase2(const Ctx& C, const Params& p, const bf16_t* U, const bf16_t* XM, bf16_t* PL, bf16_t* XC) {
    unsigned char* ws = p.ws;
    if (C.gw < 16) {
        const float* IG = (const float*)(ws + S_IG); const float* LF = (const float*)(ws + S_LF);
        float* WS = (float*)(ws + S_WS); float* EB = (float*)(ws + S_EB); float* KAP = (float*)(ws + S_KAP);
        const int bh = C.gw, b_ = bh >> 2, h = bh & 3, lane = C.lane; float mst = 0.f;
        for (int c = 0; c < 16; ++c) {
            const int s0 = c * 256 + lane * 4; float lf[4], ig[4];
#pragma unroll
            for (int e = 0; e < 4; ++e) { const size_t t = (size_t)b_ * 4096 + s0 + e; lf[e] = LF[t * 4 + h]; ig[e] = IG[t * 4 + h]; }
            const float p0 = lf[0], p1 = p0 + lf[1], p2 = p1 + lf[2], p3 = p2 + lf[3];
            float incl = p3;
#pragma unroll
            for (int o = 1; o < 64; o <<= 1) { const float y = __shfl_up(incl, o); if (lane >= o) incl += y; }
            const float off = incl - p3, bl = __shfl(incl, 63);
            float bb[4] = {off + p0, off + p1, off + p2, off + p3}; float a[4]; float am = -3.0e38f;
#pragma unroll
            for (int e = 0; e < 4; ++e) { a[e] = ig[e] - bb[e]; am = fmaxf(am, a[e]); }
            am = wave_max(am);
            const float G = fmaxf(mst, am), kap = expf(mst - G);
            f32x4 w;
#pragma unroll
            for (int e = 0; e < 4; ++e) { w[e] = expf(a[e] - G); EB[((size_t)b_ * 4096 + s0 + e) * 4 + h] = expf(-(bb[e] + G)); }
            *(f32x4*)(WS + (size_t)bh * 4096 + s0) = w;
            if (lane == 0) KAP[bh * 16 + c] = kap;
            mst = bl + G;
        }
    }
    const float* conv_w = p.in[2]; const float* conv_b = p.in[3];
    for (int idx = C.gtid; idx < 1024 * 128; idx += C.ngt) {
        const int cb = idx & 127, r = idx >> 7, t0 = r * 16, s0 = t0 & 4095, c0 = cb * 8;
        {
            const int w = 2 << (cb >> 5); const bf16_t* up = U + (size_t)t0 * 1024 + c0; bf16_t* op = PL + (size_t)t0 * 1024 + c0;
            f32x4 sa = {0.f, 0.f, 0.f, 0.f}, sb = {0.f, 0.f, 0.f, 0.f};
            for (int k = 1; k <= w; ++k) if (s0 - k >= 0) { f32x4 a, b; unpack8(*(const u32x4*)(up - (size_t)k * 1024), a, b); sa = sa + a; sb = sb + b; }
            for (int i = 0; i < 16; ++i) { f32x4 ca, cbv; unpack8(*(const u32x4*)(up + (size_t)i * 1024), ca, cbv); sa = sa + ca; sb = sb + cbv; const int s = s0 + i;
                if (s >= w) { f32x4 a, b; unpack8(*(const u32x4*)(up + (size_t)(i - w) * 1024), a, b); sa = sa - a; sb = sb - b; }
                const float inv = 1.f / (float)((s + 1) < w ? (s + 1) : w);
                *(u32x4*)(op + (size_t)i * 1024) = pack8(sa * inv - ca, sb * inv - cbv); }
        }
        {
            const bf16_t* xp = XM + (size_t)t0 * 1024 + c0; bf16_t* op = XC + (size_t)t0 * 1024 + c0;
            f32x4 w0a = *(const f32x4*)(conv_w + c0), w0b = *(const f32x4*)(conv_w + c0 + 4), w1a = *(const f32x4*)(conv_w + 1024 + c0), w1b = *(const f32x4*)(conv_w + 1024 + c0 + 4);
            f32x4 w2a = *(const f32x4*)(conv_w + 2048 + c0), w2b = *(const f32x4*)(conv_w + 2048 + c0 + 4), w3a = *(const f32x4*)(conv_w + 3072 + c0), w3b = *(const f32x4*)(conv_w + 3072 + c0 + 4);
            const f32x4 ba = *(const f32x4*)(conv_b + c0), bbv = *(const f32x4*)(conv_b + c0 + 4);
            f32x4 x0a = {0.f, 0.f, 0.f, 0.f}, x0b = x0a, x1a = x0a, x1b = x0a, x2a = x0a, x2b = x0a;
            if (s0 > 0) { unpack8(*(const u32x4*)(xp - 3 * 1024), x0a, x0b); unpack8(*(const u32x4*)(xp - 2 * 1024), x1a, x1b); unpack8(*(const u32x4*)(xp - 1024), x2a, x2b); }
            for (int i = 0; i < 16; ++i) { f32x4 x3a, x3b; unpack8(*(const u32x4*)(xp + (size_t)i * 1024), x3a, x3b);
                f32x4 ya = w0a * x0a + w1a * x1a + w2a * x2a + w3a * x3a + ba, yb = w0b * x0b + w1b * x1b + w2b * x2b + w3b * x3b + bbv;
                *(u32x4*)(op + (size_t)i * 1024) = pack8(ya * sigm4(ya), yb * sigm4(yb));
                x0a = x1a; x0b = x1b; x1a = x2a; x1b = x2b; x2a = x3a; x2b = x3b; }
        }
    }
}

__device__ __forceinline__ void dn_partials(const Ctx& C, const bf16_t* KW, float* DNP) {
    for (int it = C.gw; it < 1024; it += C.ngw) { const int L = it >> 2, kg = it & 3, bh = L >> 4, ch = L & 15;
        const bf16_t* kp = KW + ((size_t)((bh >> 2) * 4096 + ch * 256)) * 1024 + (bh & 3) * 256 + kg * 64 + C.lane; float s = 0.f;
#pragma unroll 8
        for (int t = 0; t < 256; ++t) s += __uint_as_float((unsigned)kp[(size_t)t * 1024] << 16);
        DNP[L * 256 + kg * 64 + C.lane] = s; }
}
__device__ __forceinline__ void state_scan(const Ctx& C, float* DC, const float* DNP, float* DN, const float* KAP) {
    for (int r = C.gw; r < 4096; r += C.ngw) { const int bh = r >> 8, vd = r & 255; f32x4 Cst = {0.f, 0.f, 0.f, 0.f};
        for (int c = 0; c < 16; ++c) { const float kap = KAP[bh * 16 + c]; float* rowp = DC + ((size_t)(bh * 16 + c) * 256 + vd) * 256;
            const f32x4 d = *((const f32x4*)rowp + C.lane);
            asm volatile("s_waitcnt vmcnt(0)" ::: "memory");
            const f32x4 Dv = Cst * kap; u32x2 w; w.x = cvt_pk_bf16(Dv[0], Dv[1]); w.y = cvt_pk_bf16(Dv[2], Dv[3]);
            *((u32x2*)rowp + C.lane) = w;
            asm volatile("" ::: "memory");
            Cst = Dv + d; } }
    for (int idx = C.gtid; idx < 4096; idx += C.ngt) { const int bh = idx >> 8, kd = idx & 255; float n = 0.f;
        for (int c = 0; c < 16; ++c) { const float Dn = KAP[bh * 16 + c] * n; DN[(bh * 16 + c) * 256 + kd] = Dn; n = Dn + DNP[(bh * 16 + c) * 256 + kd]; } }
}
__device__ __forceinline__ void head_norm(const Ctx& C, const Params& p, bf16_t* OUTP, const bf16_t* Q, const bf16_t* P, const bf16_t* SO) {
    const float* DN = (const float*)(p.ws + S_DN); const float* EB = (const float*)(p.ws + S_EB); const float* hng = p.in[8];
    for (int r = C.gw; r < T * 4; r += C.ngw) { const int t = r >> 2, h = r & 3, b_ = t >> 12, s = t & 4095, ch = s >> 8, i = s & 255, L = (b_ * 4 + h) * 16 + ch;
        const size_t off = (size_t)t * 1024 + h * 256 + 4 * C.lane;
        const u32x2 o2 = *(const u32x2*)(OUTP + off), q2 = *(const u32x2*)(Q + off), s2 = *(const u32x2*)(SO + off), p2 = *(const u32x2*)(P + ((size_t)L * 256 + i) * 256 + 4 * C.lane);
        const f32x4 dn = *(const f32x4*)(DN + L * 256 + 4 * C.lane), g = *(const f32x4*)(hng + h * 256 + 4 * C.lane);
        float den = (bf_lo(q2.x) * dn[0] + bf_hi(q2.x) * dn[1]) + (bf_lo(q2.y) * dn[2] + bf_hi(q2.y) * dn[3]) + (bf_lo(p2.x) + bf_hi(p2.x)) + (bf_lo(p2.y) + bf_hi(p2.y));
        den = wave_sum(den);
        const float inv = 1.f / fmaxf(fabsf(den), EB[(size_t)t * 4 + h]);
        f32x4 hv = {bf_lo(o2.x) * inv, bf_hi(o2.x) * inv, bf_lo(o2.y) * inv, bf_hi(o2.y) * inv};
        const float mu = wave_sum((hv[0] + hv[1]) + (hv[2] + hv[3])) * (1.f / 256.f);
        hv = hv - mu;
        const float var = wave_sum((hv[0] * hv[0] + hv[1] * hv[1]) + (hv[2] * hv[2] + hv[3] * hv[3])) * (1.f / 256.f);
        const float rstd = 1.f / sqrtf(var + HN_EPS);
        const f32x4 so = {bf_lo(s2.x), bf_hi(s2.x), bf_lo(s2.y), bf_hi(s2.y)};
        const f32x4 y = hv * rstd * g * so; u32x2 w; w.x = cvt_pk_bf16(y[0], y[1]); w.y = cvt_pk_bf16(y[2], y[3]);
        *(u32x2*)(OUTP + off) = w; }
}
__device__ __forceinline__ void ln_rows(const Ctx& C, const float* in, float* out, bf16_t* outb, const float* g, const float* b) {
    f32x4 gv[4], bv[4];
#pragma unroll
    for (int j = 0; j < 4; ++j) { gv[j] = *((const f32x4*)g + C.lane + 64 * j); bv[j] = *((const f32x4*)b + C.lane + 64 * j); }
    for (int row = C.gw; row < T; row += C.ngw) { const f32x4* xr = (const f32x4*)(in + (size_t)row * 1024) + C.lane; f32x4 v[4]; float s = 0.f;
#pragma unroll
        for (int j = 0; j < 4; ++j) { v[j] = xr[64 * j]; s += (v[j][0] + v[j][1]) + (v[j][2] + v[j][3]); }
        const float mean = wave_sum(s) * (1.f / 1024.f); float s2 = 0.f;
#pragma unroll
        for (int j = 0; j < 4; ++j) { v[j] = v[j] - mean; s2 += (v[j][0] * v[j][0] + v[j][1] * v[j][1]) + (v[j][2] * v[j][2] + v[j][3] * v[j][3]); }
        const float rstd = 1.f / sqrtf(wave_sum(s2) * (1.f / 1024.f) + LN_EPS);
        f32x4* orow = (f32x4*)(out + (size_t)row * 1024) + C.lane;
#pragma unroll
        for (int j = 0; j < 4; ++j) { const f32x4 y = v[j] * rstd * gv[j] + bv[j]; orow[64 * j] = y;
            if (outb) { u32x2 w; w.x = cvt_pk_bf16(y[0], y[1]); w.y = cvt_pk_bf16(y[2], y[3]); *((u32x2*)(outb + (size_t)row * 1024) + C.lane + 64 * j) = w; } } }
}

constexpr int LDS_BYTES = 131072;
__global__ void __launch_bounds__(512, 2) hybrid_fwd(Params p) {
    extern __shared__ __attribute__((aligned(16))) unsigned char lds_raw[];
    cg::grid_group grid = cg::this_grid();
    typedef const __attribute__((address_space(4))) Params* KP;
    KP pp = (KP)__builtin_amdgcn_kernarg_segment_ptr();
#define MKCTX() Ctx C; C.lds = (LAS unsigned char*)lds_raw; C.tid = threadIdx.x; C.lane = C.tid & 63; C.wave = __builtin_amdgcn_readfirstlane(C.tid >> 6); \
    const int G = gridDim.x, bx = blockIdx.x; C.gw = bx * 8 + C.wave; C.ngw = G * 8; C.gtid = bx * 512 + C.tid; C.ngt = G * 512; (void)G; (void)bx
#define PH_BEGIN() asm volatile("" : "+s"(pp)); Params p; _Pragma("unroll") for (int _i = 0; _i < 20; ++_i) p.in[_i] = pp->in[_i]; p.out = pp->out; p.ws = pp->ws; MKCTX(); unsigned char* ws = p.ws; unsigned char* ob = (unsigned char*)p.out; const char* cws = (const char*)ws; (void)ob; (void)cws
#define GSYNC() do { asm volatile("s_waitcnt vmcnt(0) lgkmcnt(0)" ::: "memory"); __threadfence(); grid.sync(); __builtin_amdgcn_fence(__ATOMIC_ACQUIRE, "agent"); } while (0)
#define SL(k) (ws + SLOT0 + (size_t)(k) * SLOT)
#define B_XB ((bf16_t*)SL(0))
#define B_U ((bf16_t*)SL(1))
#define B_XM ((bf16_t*)SL(2))
#define B_SO ((bf16_t*)SL(3))
#define B_VT ((bf16_t*)SL(4))
#define B_PL ((bf16_t*)SL(5))
#define B_XC ((bf16_t*)SL(6))
#define B_P2B ((bf16_t*)SL(1))
#define B_Q ((bf16_t*)SL(2))
#define B_KW ((bf16_t*)ob)
#define B_KT ((bf16_t*)(ob + SLOT))
#define B_DC ((float*)SL(5))
#define B_P ((bf16_t*)(ob + SLOT))
#define B_OUTP ((bf16_t*)ob)
#define B_PO ((bf16_t*)SL(2))
#define B_SGP ((bf16_t*)SL(3))
#define B_SGM ((bf16_t*)SL(4))
#define B_MG ((bf16_t*)SL(5))
#define B_Y (p.out)
#define B_X1 ((float*)SL(0))
#define B_X1B ((bf16_t*)SL(2))
#define B_HID ((bf16_t*)SL(3))

    { PH_BEGIN(); phase0(C, p); }
    GSYNC();
    { PH_BEGIN(); SchedMN S{(const char*)B_XB, cws + W_CAT, 64, 12, 768, G, bx, (size_t)256 * 2048, 0, (size_t)256 * 2048, 0}; EpiSec<2> E{B_U, SLOT / 2};
      pg8::gemm_phase<EpiSec<2>, SchedMN>(C.lds, 1024, 1024, 1024, S, E); }
    { PH_BEGIN(); SchedMN S{cws + W_VT, (const char*)B_XB, 4, 64, 256, G, bx, (size_t)256 * 2048, 0, (size_t)256 * 2048, 0}; EpiT<0> E{B_VT, nullptr};
      pg8::gemm_phase<EpiT<0>, SchedMN>(C.lds, 1024, 1024, 1024, S, E); }
    GSYNC();
    { PH_BEGIN(); phase2(C, p, B_U, B_XM, B_PL, B_XC); }
    GSYNC();
    { PH_BEGIN(); SchedMN S{(const char*)B_PL, cws + W_PW, 64, 4, 256, G, bx, (size_t)256 * 2048, 512, (size_t)256 * 512, 0}; EpiScale<0> E{B_P2B, p.in[10]};
      pg8::gemm_phase<EpiScale<0>, SchedMN>(C.lds, 256, 1024, 256, S, E); }
    { PH_BEGIN(); SchedMN S{(const char*)B_XC, cws + W_Q, 64, 4, 256, G, bx, (size_t)256 * 2048, 512, (size_t)256 * 512, 0}; EpiSec<9> E{B_Q, 256};
      pg8::gemm_phase<EpiSec<9>, SchedMN>(C.lds, 256, 1024, 256, S, E); }
    { PH_BEGIN(); SchedMN S{(const char*)B_XC, cws + W_K, 64, 4, 256, G, bx, (size_t)256 * 2048, 512, (size_t)256 * 512, 0}; EpiScale<1> E{B_KW, (const float*)(ws + S_WS)};
      pg8::gemm_phase<EpiScale<1>, SchedMN>(C.lds, 256, 1024, 256, S, E); }
    { PH_BEGIN(); SchedMN S{cws + W_K, (const char*)B_XC, 4, 64, 256, G, bx, (size_t)256 * 512, 0, (size_t)256 * 2048, 512}; EpiT<1> E{B_KT, (const float*)(ws + S_WS)};
      pg8::gemm_phase<EpiT<1>, SchedMN>(C.lds, 256, 256, 1024, S, E); }
    GSYNC();
    { PH_BEGIN(); Sched4 S{(const char*)B_VT, (const char*)B_KT, G, bx}; Epi4 E{B_DC};
      pg8::gemm_phase<Epi4, Sched4>(C.lds, 256, 4096, 4096, S, E); }
    { PH_BEGIN(); dn_partials(C, B_KW, (float*)(ws + S_DNP)); }
    GSYNC();
    { PH_BEGIN(); Sched5 S{(const char*)B_Q, (const char*)B_KW, G, bx}; Epi5 E{B_P};
      pg8::gemm_phase<Epi5, Sched5>(C.lds, 256, 1024, 1024, S, E); }
    { PH_BEGIN(); state_scan(C, B_DC, (const float*)(ws + S_DNP), (float*)(ws + S_DN), (const float*)(ws + S_KAP)); }
    GSYNC();
    { PH_BEGIN(); Sched6<0> S{(const char*)B_Q, (const char*)B_DC, G, bx}; Epi6<0> E{B_OUTP};
      pg8::gemm_phase<Epi6<0>, Sched6<0>>(C.lds, 256, 1024, 512, S, E); }
    { PH_BEGIN(); Sched6<1> S{(const char*)B_P, (const char*)B_VT, G, bx}; Epi6<1> E{B_OUTP};
      pg8::gemm_phase<Epi6<1>, Sched6<1>>(C.lds, 256, 256, 4096, S, E); }
    GSYNC();
    { PH_BEGIN(); head_norm(C, p, B_OUTP, B_Q, B_P, B_SO); }
    GSYNC();
    { PH_BEGIN(); SchedMN S{(const char*)B_P2B, cws + W_PP, 64, 4, 256, G, bx, (size_t)256 * 2048, 0, (size_t)256 * 2048, 0}; EpiSec<9> E{B_PO, 256};
      pg8::gemm_phase<EpiSec<9>, SchedMN>(C.lds, 1024, 1024, 1024, S, E); }
    { PH_BEGIN(); SchedMN S{(const char*)B_XB, cws + W_G, 64, 8, 512, G, bx, (size_t)256 * 2048, 0, (size_t)256 * 2048, 0}; EpiSec<0> E{B_SGP, SLOT / 2};
      pg8::gemm_phase<EpiSec<0>, SchedMN>(C.lds, 1024, 1024, 1024, S, E); }
    GSYNC();
    { PH_BEGIN(); SchedMN S{(const char*)B_OUTP, cws + W_M, 64, 4, 256, G, bx, (size_t)256 * 2048, 0, (size_t)256 * 2048, 0}; Epi9 E{B_PO, B_SGP, B_SGM, B_MG};
      pg8::gemm_phase<Epi9, SchedMN>(C.lds, 1024, 1024, 1024, S, E); }
    GSYNC();
    { PH_BEGIN(); SchedMN S{(const char*)B_MG, cws + W_O, 64, 4, 256, G, bx, (size_t)256 * 2048, 0, (size_t)256 * 2048, 0}; EpiRes E{p.in[0], B_Y};
      pg8::gemm_phase<EpiRes, SchedMN>(C.lds, 1024, 1024, 1024, S, E); }
    GSYNC();
    { PH_BEGIN(); ln_rows(C, B_Y, B_X1, B_X1B, p.in[14], p.in[15]); late_weights(C, p); }
    GSYNC();
    { PH_BEGIN(); SchedMN S{(const char*)B_X1B, cws + W_UP, 64, 16, 1024, G, bx, (size_t)256 * 2048, 0, (size_t)256 * 2048, 0}; EpiUp E{B_HID};
      pg8::gemm_phase<EpiUp, SchedMN>(C.lds, 1024, 1024, 1024, S, E); }
    GSYNC();
    { PH_BEGIN(); SchedMN S{(const char*)B_HID, cws + W_DN, 64, 4, 256, G, bx, (size_t)256 * 8192, 0, (size_t)256 * 8192, 0}; EpiRes E{B_X1, B_Y};
      pg8::gemm_phase<EpiRes, SchedMN>(C.lds, 4096, 4096, 4096, S, E); }
    GSYNC();
    { PH_BEGIN(); ln_rows(C, B_Y, B_Y, nullptr, p.in[18], p.in[19]); }
}

extern "C" void kernel_launch(void* const* d_in, const int* in_sizes, int n_in, void* d_out, int out_size, void* d_ws, size_t ws_size, hipStream_t stream) {
    static int grid = 0;
    if (grid == 0) {
        if (n_in != 20 || in_sizes[0] != T * DM || out_size != T * DM || ws_size < WS_NEED) { fprintf(stderr, "kernel_launch: unexpected shapes (n_in %d, in0 %d, out %d, ws %zu)\n", n_in, n_in > 0 ? in_sizes[0] : -1, out_size, ws_size); grid = -1; return; }
        int dev = 0, cus = 0, per_cu = 0;
        hipGetDevice(&dev); hipDeviceGetAttribute(&cus, hipDeviceAttributeMultiprocessorCount, dev);
        hipFuncSetAttribute((const void*)hybrid_fwd, hipFuncAttributeMaxDynamicSharedMemorySize, LDS_BYTES);
        hipOccupancyMaxActiveBlocksPerMultiprocessor(&per_cu, (const void*)hybrid_fwd, 512, LDS_BYTES);
        if (per_cu < 1) per_cu = 1;
        grid = cus * 1;
        (void)hipGetLastError();
    }
    if (grid < 0) return;
    Params p{};
    for (int i = 0; i < 20; ++i) p.in[i] = (const float*)d_in[i];
    p.out = (float*)d_out; p.ws = (unsigned char*)d_ws;
    void* args[] = {&p};
    hipError_t e = hipLaunchCooperativeKernel((const void*)hybrid_fwd, dim3(grid), dim3(512), args, LDS_BYTES, stream);
    if (e != hipSuccess) fprintf(stderr, "cooperative launch failed: %s (grid %d)\n", hipGetErrorString(e), grid);
}
```

```cpp
#include <hip/hip_runtime.h>
#include <hip/hip_cooperative_groups.h>
#include <cstdio>
#include <cstdint>
namespace cg = cooperative_groups;

namespace pg8 {
#define PG8_LAS __attribute__((address_space(3)))
typedef unsigned short bf16_t;
typedef short bf16x8 __attribute__((ext_vector_type(8)));
typedef float f32x4 __attribute__((ext_vector_type(4)));
typedef unsigned u32x4 __attribute__((ext_vector_type(4)));
constexpr int BM = 256, BK = 64, HALF = 128, HTB = HALF * BK * 2  , STAGE_BYTES = 8 * HTB;

__host__ __device__ __forceinline__ int lds_byte(int r, int c) { const int st = (r >> 4) * 2 + (c >> 5), rr = r & 15, cc = c & 31, ob = rr * 64 + cc * 2; return st * 1024 + (ob ^ (((ob >> 9) & 1) << 5)); }
__host__ __device__ __forceinline__ void stage_rc(int b, int& R, int& C) { const int st = b / 1024, sb = b % 1024, swz = sb ^ (((sb >> 9) & 1) << 5); R = (st >> 1) * 16 + swz / 64; C = (st & 1) * 32 + (swz % 64) / 2; }
__host__ __device__ __forceinline__ int perm32(int rho) { const int n = rho >> 4, i = rho & 15; return 8 * (i >> 2) + 4 * n + (i & 3); }

struct Unit { int pm, pn, kind; const char* a; const char* b; };

__device__ __forceinline__ void tmpl_decode(int wgid, int nM, int nN, int& pm, int& pn) {
    const int nwg = nM * nN;
    { const int q = nwg / 8, r = nwg % 8, xcd = wgid % 8, off = wgid / 8; wgid = (xcd < r ? xcd * (q + 1) : r * (q + 1) + (xcd - r) * q) + off; }
    const int nig = 8 * nN, gid = wgid / nig, fm = gid * 8, gsz = (nM - fm) < 8 ? (nM - fm) : 8;
    pm = fm + ((wgid % nig) % gsz); pn = (wgid % nig) / gsz;
}

template <class Epi, class Sched, bool ALIGN_EPI = true, bool SP2 = true>
__device__ __forceinline__ void gemm_phase(PG8_LAS unsigned char* lds, const int K, const int lda, const int ldb, const Sched& S, const Epi& E) {
    int tid_ = threadIdx.x; asm volatile("" : "+v"(tid_));
    const int tid = tid_, wid = __builtin_amdgcn_readfirstlane(tid >> 6), lane = tid & 63, wr = wid >> 2, wc = wid & 3, fr = lane & 15, fq = lane >> 4;
    int nt = K / BK; asm volatile("" : "+s"(nt));
    unsigned voffA[2], voffB[2];
#pragma unroll
    for (int i = 0; i < 2; ++i) { int R, C; stage_rc(tid * 16 + i * 8192, R, C); const int Rb = Epi::PERM ? ((R & ~31) + perm32(R & 31)) : R;
        voffA[i] = (unsigned)(R * lda + C) * 2u; voffB[i] = (unsigned)(Rb * ldb + C) * 2u; }
    const size_t kstep = (size_t)(BK * 2);
    const size_t hstepA = (size_t)HALF * lda * 2, hstepB = (size_t)HALF * ldb * 2;
    const unsigned ldsw = (unsigned)wid * 1024u;
    const int aoff = lds_byte(wr * 64 + fr, fq * 8), boff = lds_byte(wc * 32 + fr, fq * 8);
#define PG8_SA(b, h) (((b) * 2 + (h)) * HTB)
#define PG8_SB(b, h) ((4 + (b) * 2 + (h)) * HTB)
#define PG8_STAGE(bufoff, gbase, voff) do { _Pragma("unroll") for (int _i = 0; _i < 2; ++_i) \
        __builtin_amdgcn_global_load_lds((const unsigned*)((const char*)(gbase) + (voff)[_i]), (PG8_LAS unsigned*)(lds + (bufoff) + ldsw + _i * 8192), 16, 0, 0); } while (0)
#define PG8_LDA(dst, b, h) do { _Pragma("unroll") for (int m = 0; m < 4; ++m) _Pragma("unroll") for (int k = 0; k < 2; ++k) dst[m][k] = *(const PG8_LAS bf16x8*)(lds + PG8_SA(b, h) + aoff + m * 2048 + k * 1024); } while (0)
#define PG8_LDB(dst, b, h) do { _Pragma("unroll") for (int n = 0; n < 2; ++n) _Pragma("unroll") for (int k = 0; k < 2; ++k) dst[n][k] = *(const PG8_LAS bf16x8*)(lds + PG8_SB(b, h) + boff + n * 2048 + k * 1024); } while (0)
#define PG8_MMA(ai, bj, At, Bt) do { __builtin_amdgcn_s_setprio(1); _Pragma("unroll") for (int m = 0; m < 4; ++m) _Pragma("unroll") for (int n = 0; n < 2; ++n) _Pragma("unroll") for (int k = 0; k < 2; ++k) \
        acc[ai][bj][m][n] = __builtin_amdgcn_mfma_f32_16x16x32_bf16(Bt[n][k], At[m][k], acc[ai][bj][m][n], 0, 0, 0); __builtin_amdgcn_s_setprio(0); } while (0)
#define PG8_WAIT_V(n) asm volatile("s_waitcnt vmcnt(" #n ")" ::: "memory")
#define PG8_WAIT_L(n) asm volatile("s_waitcnt lgkmcnt(" #n ")" ::: "memory")
#define PG8_BAR __builtin_amdgcn_s_barrier()
#define PG8_SCHED __builtin_amdgcn_sched_barrier(0)
    Unit cur, nxt; int ui = 0;
    if (!S.next(0, cur)) return;
    f32x4 acc[2][2][4][2];
#pragma unroll
    for (int a = 0; a < 2; ++a)
#pragma unroll
        for (int b = 0; b < 2; ++b)
#pragma unroll
            for (int m = 0; m < 4; ++m)
#pragma unroll
                for (int n = 0; n < 2; ++n) acc[a][b][m][n] = (f32x4){0.f, 0.f, 0.f, 0.f};
    bf16x8 At[4][2], B0[2][2], B1[2][2];
    const char* cA = cur.a; const char* cB = cur.b;
    if constexpr (SP2) {
        PG8_STAGE(PG8_SB(0, 0), cB, voffB); PG8_STAGE(PG8_SB(0, 1), cB + hstepB, voffB); PG8_STAGE(PG8_SA(0, 0), cA, voffA); PG8_STAGE(PG8_SA(0, 1), cA + hstepA, voffA);
        if (wr == 1) PG8_BAR;
        PG8_WAIT_V(2); PG8_BAR;
        PG8_STAGE(PG8_SB(1, 0), cB + kstep, voffB); PG8_STAGE(PG8_SA(1, 0), cA + kstep, voffA); PG8_STAGE(PG8_SB(1, 1), cB + hstepB + kstep, voffB);
        PG8_WAIT_V(6); PG8_BAR;
    } else {
        PG8_STAGE(PG8_SB(0, 0), cB, voffB); PG8_STAGE(PG8_SA(0, 0), cA, voffA); PG8_STAGE(PG8_SB(0, 1), cB + hstepB, voffB); PG8_STAGE(PG8_SA(0, 1), cA + hstepA, voffA);
        if (wr == 1) PG8_BAR;
        PG8_WAIT_V(4); PG8_BAR;
        PG8_STAGE(PG8_SB(1, 0), cB + kstep, voffB); PG8_STAGE(PG8_SA(1, 0), cA + kstep, voffA); PG8_STAGE(PG8_SB(1, 1), cB + hstepB + kstep, voffB);
        PG8_WAIT_V(6); PG8_BAR;
    }
    for (;;) {
        const bool has_next = S.next(ui + 1, nxt);
        const char* nA = has_next ? nxt.a : cA; const char* nB = has_next ? nxt.b : cB;
#pragma nounroll
        for (int t = 0; t < nt; t += 2) {
            const bool last = (t == nt - 2);
            const char* a1 = cA + (size_t)(t + 1) * kstep;
            const char* a2 = last ? nA : cA + (size_t)(t + 2) * kstep; const char* b2 = last ? nB : cB + (size_t)(t + 2) * kstep;
            const char* a3 = a2 + kstep; const char* b3 = b2 + kstep;
            if constexpr (SP2) {
            PG8_LDB(B0, 0, 0); PG8_LDB(B1, 0, 1); PG8_SCHED; PG8_LDA(At, 0, 0); PG8_STAGE(PG8_SA(1, 1), a1 + hstepA, voffA);
            PG8_WAIT_V(8); PG8_WAIT_L(0); PG8_BAR; PG8_MMA(0, 0, At, B0); PG8_MMA(0, 1, At, B1); PG8_BAR; PG8_SCHED;
            PG8_LDA(At, 0, 1); PG8_STAGE(PG8_SB(0, 0), b2, voffB); PG8_STAGE(PG8_SB(0, 1), b2 + hstepB, voffB); PG8_STAGE(PG8_SA(0, 0), a2, voffA);
            PG8_WAIT_V(8); PG8_WAIT_L(0); PG8_BAR; PG8_MMA(1, 0, At, B0); PG8_MMA(1, 1, At, B1); PG8_BAR; PG8_SCHED;
            PG8_LDB(B0, 1, 0); PG8_LDB(B1, 1, 1); PG8_SCHED; PG8_LDA(At, 1, 0); PG8_STAGE(PG8_SA(0, 1), a2 + hstepA, voffA);
            PG8_WAIT_V(8); PG8_WAIT_L(0); PG8_BAR; PG8_MMA(0, 0, At, B0); PG8_MMA(0, 1, At, B1); PG8_BAR; PG8_SCHED;
            PG8_LDA(At, 1, 1); PG8_STAGE(PG8_SB(1, 0), b3, voffB); PG8_STAGE(PG8_SB(1, 1), b3 + hstepB, voffB); PG8_STAGE(PG8_SA(1, 0), a3, voffA);
            PG8_WAIT_V(8); PG8_WAIT_L(0); PG8_BAR; PG8_MMA(1, 0, At, B0); PG8_MMA(1, 1, At, B1); PG8_BAR; PG8_SCHED;
            } else {
            PG8_LDB(B0, 0, 0); PG8_SCHED; PG8_LDA(At, 0, 0); PG8_STAGE(PG8_SA(1, 1), a1 + hstepA, voffA);
            PG8_WAIT_L(8); PG8_BAR; PG8_WAIT_L(0); PG8_MMA(0, 0, At, B0); PG8_BAR; PG8_SCHED;
            PG8_LDB(B1, 0, 1); PG8_STAGE(PG8_SB(0, 0), b2, voffB);
            PG8_BAR; PG8_WAIT_L(0); PG8_MMA(0, 1, At, B1); PG8_BAR;
            PG8_LDA(At, 0, 1); PG8_STAGE(PG8_SA(0, 0), a2, voffA);
            PG8_BAR; PG8_WAIT_L(0); PG8_MMA(1, 0, At, B0); PG8_BAR; PG8_SCHED;
            PG8_STAGE(PG8_SB(0, 1), b2 + hstepB, voffB);
            PG8_WAIT_V(6); PG8_BAR; PG8_MMA(1, 1, At, B1); PG8_BAR;
            PG8_LDB(B0, 1, 0); PG8_SCHED; PG8_LDA(At, 1, 0); PG8_STAGE(PG8_SA(0, 1), a2 + hstepA, voffA);
            PG8_WAIT_L(8); PG8_BAR; PG8_WAIT_L(0); PG8_MMA(0, 0, At, B0); PG8_BAR; PG8_SCHED;
            PG8_LDB(B1, 1, 1); PG8_STAGE(PG8_SB(1, 0), b3, voffB);
            PG8_BAR; PG8_WAIT_L(0); PG8_MMA(0, 1, At, B1); PG8_BAR;
            PG8_LDA(At, 1, 1); PG8_STAGE(PG8_SA(1, 0), a3, voffA);
            PG8_BAR; PG8_WAIT_L(0); PG8_MMA(1, 0, At, B0); PG8_BAR; PG8_SCHED;
            PG8_STAGE(PG8_SB(1, 1), b3 + hstepB, voffB);
            PG8_WAIT_V(6); PG8_BAR; PG8_MMA(1, 1, At, B1); PG8_BAR;
            }
        }
        if constexpr (ALIGN_EPI) { if (wr == 0) PG8_BAR; }
        if constexpr (!Epi::AFTER_DRAIN) { E(acc, cur, wr, wc, fr, fq); }
        if (!has_next) break;
#pragma unroll
        for (int a = 0; a < 2; ++a)
#pragma unroll
            for (int b = 0; b < 2; ++b)
#pragma unroll
                for (int m = 0; m < 4; ++m)
#pragma unroll
                    for (int n = 0; n < 2; ++n) acc[a][b][m][n] = (f32x4){0.f, 0.f, 0.f, 0.f};
        cur = nxt; cA = nA; cB = nB; ++ui;
        if constexpr (ALIGN_EPI) { if (wr == 1) PG8_BAR; }
    }
    PG8_WAIT_V(0);
    if constexpr (!ALIGN_EPI) { if (wr == 0) PG8_BAR; }
    PG8_BAR;
#undef PG8_SA
#undef PG8_SB
#undef PG8_STAGE
#undef PG8_LDA
#undef PG8_LDB
#undef PG8_MMA
#undef PG8_WAIT_V
#undef PG8_WAIT_L
#undef PG8_BAR
#undef PG8_SCHED
}
}

using pg8::Unit; using pg8::bf16_t; using pg8::f32x4; using pg8::u32x4; using pg8::tmpl_decode;
#define LAS __attribute__((address_space(3)))
typedef unsigned u32x2 __attribute__((ext_vector_type(2)));
#define LDS_WAIT() asm volatile("s_waitcnt lgkmcnt(0)" ::: "memory")

constexpr int T = 16384, DM = 1024, SEQ = 4096, FF = 4096, INW = 6152;
constexpr float ALPHA = 1.18920711500272f;
constexpr float LN_EPS = 1e-5f, HN_EPS = 1e-6f;
constexpr size_t MiB = 1u << 20;
constexpr size_t W_CAT = 0, W_G = 6 * MiB, W_VT = 10 * MiB, W_PP = 12 * MiB, W_M = 14 * MiB, W_O = 16 * MiB, W_PW = 18 * MiB, W_Q = 18 * MiB + 512 * 1024, W_K = 19 * MiB;
constexpr size_t W_UP = 0, W_DN = 8 * MiB;
constexpr size_t S_IG = 24 * MiB, S_LF = S_IG + 256 * 1024, S_WS = S_LF + 256 * 1024, S_EB = S_WS + 256 * 1024, S_DNP = 25 * MiB, S_DN = S_DNP + 256 * 1024, S_KAP = S_DN + 256 * 1024;
constexpr size_t SLOT0 = 32 * MiB, SLOT = 32 * MiB;
constexpr size_t WS_NEED = 256 * MiB;

__device__ __forceinline__ unsigned cvt_pk_bf16(float lo, float hi) { unsigned r; asm("v_cvt_pk_bf16_f32 %0, %1, %2" : "=v"(r) : "v"(lo), "v"(hi)); return r; }
__device__ __forceinline__ float bf_lo(unsigned w) { return __uint_as_float(w << 16); }
__device__ __forceinline__ float bf_hi(unsigned w) { return __uint_as_float(w & 0xffff0000u); }
__device__ __forceinline__ u32x4 pack8(f32x4 a, f32x4 b) { u32x4 w; w.x = cvt_pk_bf16(a[0], a[1]); w.y = cvt_pk_bf16(a[2], a[3]); w.z = cvt_pk_bf16(b[0], b[1]); w.w = cvt_pk_bf16(b[2], b[3]); return w; }
__device__ __forceinline__ void unpack8(u32x4 w, f32x4& a, f32x4& b) { a[0] = bf_lo(w.x); a[1] = bf_hi(w.x); a[2] = bf_lo(w.y); a[3] = bf_hi(w.y); b[0] = bf_lo(w.z); b[1] = bf_hi(w.z); b[2] = bf_lo(w.w); b[3] = bf_hi(w.w); }
__device__ __forceinline__ float sigm(float x) { return __builtin_amdgcn_rcpf(1.f + __expf(-x)); }
__device__ __forceinline__ f32x4 sigm4(f32x4 v) { f32x4 r; r[0] = sigm(v[0]); r[1] = sigm(v[1]); r[2] = sigm(v[2]); r[3] = sigm(v[3]); return r; }
__device__ __forceinline__ float wave_sum(float v) {
#pragma unroll
    for (int o = 1; o < 64; o <<= 1) v += __shfl_xor(v, o);
    return v;
}
__device__ __forceinline__ float wave_max(float v) {
#pragma unroll
    for (int o = 1; o < 64; o <<= 1) v = fmaxf(v, __shfl_xor(v, o));
    return v;
}

#define EPI_HEAD static constexpr bool PERM = true, AFTER_DRAIN = false;
#define EPI_SIG (const f32x4 (&acc)[2][2][4][2], const Unit& u, int wr, int wc, int fr, int fq) const
#define EPI_FOR_ROWS _Pragma("unroll") for (int ai = 0; ai < 2; ++ai) _Pragma("unroll") for (int m = 0; m < 4; ++m)
#define EPI_FOR_COLS _Pragma("unroll") for (int bj = 0; bj < 2; ++bj)
#define EPI_LROW (ai * 128 + wr * 64 + m * 16 + fr)
#define EPI_LCOL (bj * 128 + wc * 32 + 8 * fq)

struct SchedMN { const char *A, *B; int nM, nN, nU, G, c; size_t sa, apn, sb, bpm;
    __device__ __forceinline__ bool next(int i, Unit& u) const { const int L = i * G + c; if (L >= nU) return false;
        tmpl_decode(L, nM, nN, u.pm, u.pn); u.kind = 0; u.a = A + (size_t)u.pm * sa + (size_t)u.pn * apn; u.b = B + (size_t)u.pn * sb + (size_t)u.pm * bpm; return true; } };
template <int SIGSEC> struct EpiSec { EPI_HEAD bf16_t* base; size_t secstride;
    __device__ __forceinline__ void operator() EPI_SIG {
        const int sec = u.pn >> 2; bf16_t* bp = base + (size_t)sec * secstride + (u.pn & 3) * 256;
        EPI_FOR_ROWS { const int row = u.pm * 256 + EPI_LROW;
            EPI_FOR_COLS { f32x4 v0 = acc[ai][bj][m][0], v1 = acc[ai][bj][m][1];
                if (sec >= SIGSEC) { v0 = sigm4(v0); v1 = sigm4(v1); }
                *(u32x4*)(bp + (size_t)row * 1024 + EPI_LCOL) = pack8(v0, v1); } } } };
template <int WEIGHT> struct EpiT { EPI_HEAD bf16_t* DST; const float* WS;
    __device__ __forceinline__ void operator() EPI_SIG {
        EPI_FOR_ROWS { const int rowl = u.pm * 256 + EPI_LROW;
            EPI_FOR_COLS { const int tok = u.pn * 256 + EPI_LCOL, b_ = tok >> 12, s = tok & 4095; f32x4 v0 = acc[ai][bj][m][0], v1 = acc[ai][bj][m][1];
                if (WEIGHT) { const float* wp = WS + (size_t)(b_ * 4 + u.pm) * 4096 + s; v0 = v0 * *(const f32x4*)wp; v1 = v1 * *(const f32x4*)(wp + 4); }
                *(u32x4*)(DST + ((size_t)(b_ * 1024 + rowl)) * 4096 + s) = pack8(v0, v1); } } } };
template <int MODE> struct EpiScale { EPI_HEAD bf16_t* DST; const float* sc;
    __device__ __forceinline__ void operator() EPI_SIG {
        EPI_FOR_ROWS { const int row = u.pm * 256 + EPI_LROW; float rs = 1.f;
            if (MODE == 1) rs = sc[(size_t)((row >> 12) * 4 + u.pn) * 4096 + (row & 4095)];
            EPI_FOR_COLS { const int col = u.pn * 256 + EPI_LCOL; f32x4 v0 = acc[ai][bj][m][0], v1 = acc[ai][bj][m][1];
                if (MODE == 0) { v0 = v0 * *(const f32x4*)(sc + col); v1 = v1 * *(const f32x4*)(sc + col + 4); }
                else { v0 = v0 * rs; v1 = v1 * rs; }
                *(u32x4*)(DST + (size_t)row * 1024 + col) = pack8(v0, v1); } } } };
struct Sched4 { const char *VT, *KT; int G, c;
    __device__ __forceinline__ bool next(int i, Unit& u) const { const int L = i * G + c; if (L >= 256) return false;
        u.pm = L; u.pn = 0; u.kind = 0; const size_t off = ((size_t)(L >> 4) * 256 * 4096 + (size_t)(L & 15) * 256) * 2; u.a = VT + off; u.b = KT + off; return true; } };
struct Epi4 { EPI_HEAD float* DC;
    __device__ __forceinline__ void operator() EPI_SIG {
        EPI_FOR_ROWS { float* rp = DC + ((size_t)u.pm * 256 + EPI_LROW) * 256;
            EPI_FOR_COLS { *(f32x4*)(rp + EPI_LCOL) = acc[ai][bj][m][0]; *(f32x4*)(rp + EPI_LCOL + 4) = acc[ai][bj][m][1]; } } } };
struct Sched5 { const char *Q, *KW; int G, c;
    __device__ __forceinline__ bool next(int i, Unit& u) const { const int L = i * G + c; if (L >= 256) return false;
        u.pm = L; u.pn = 0; u.kind = 0; const int bh = L >> 4, ch = L & 15; const size_t off = ((size_t)((bh >> 2) * 4096 + ch * 256) * 1024 + (size_t)(bh & 3) * 256) * 2; u.a = Q + off; u.b = KW + off; return true; } };
struct Epi5 { EPI_HEAD bf16_t* P;
    __device__ __forceinline__ void operator() EPI_SIG {
        asm volatile("" : "+v"(fr));
        EPI_FOR_ROWS { const int i = EPI_LROW; bf16_t* rp = P + ((size_t)u.pm * 256 + i) * 256;
            EPI_FOR_COLS { const int j0 = EPI_LCOL; f32x4 v0 = acc[ai][bj][m][0], v1 = acc[ai][bj][m][1];
#pragma unroll
                for (int e = 0; e < 4; ++e) { const int lim = i - j0; v0[e] = (lim >= e) ? v0[e] : 0.f; v1[e] = (lim >= e + 4) ? v1[e] : 0.f; }
                *(u32x4*)(rp + j0) = pack8(v0, v1); __builtin_amdgcn_sched_barrier(0); } } } };
template <int MODE> struct Sched6 { const char *A, *B; int G, c;
    __device__ __forceinline__ bool next(int i, Unit& u) const { const int L = i * G + c; if (L >= 256) return false;
        const int bh = L >> 4, ch = L & 15; u.pm = (bh >> 2) * 16 + ch; u.pn = bh & 3; u.kind = 0;
        if (MODE == 0) { u.a = A + ((size_t)((bh >> 2) * 4096 + ch * 256) * 1024 + (size_t)(bh & 3) * 256) * 2; u.b = B + (size_t)L * 256 * 1024; }
        else { u.a = A + (size_t)L * 65536 * 2; u.b = B + ((size_t)bh * 256 * 4096 + (size_t)ch * 256) * 2; }
        return true; } };
template <int ADD> struct Epi6 { EPI_HEAD bf16_t* OUTP;
    __device__ __forceinline__ void operator() EPI_SIG {
        EPI_FOR_ROWS { const int row = u.pm * 256 + EPI_LROW;
            EPI_FOR_COLS { const int col = u.pn * 256 + EPI_LCOL; f32x4 v0 = acc[ai][bj][m][0], v1 = acc[ai][bj][m][1]; u32x4* p = (u32x4*)(OUTP + (size_t)row * 1024 + col);
                if (ADD) { f32x4 o0, o1; unpack8(*p, o0, o1); v0 = v0 + o0; v1 = v1 + o1; }
                *p = pack8(v0, v1); } } } };
struct Epi9 { EPI_HEAD const bf16_t *PO, *SGP, *SGM; bf16_t* MG;
    __device__ __forceinline__ void operator() EPI_SIG {
        EPI_FOR_ROWS { const int row = u.pm * 256 + EPI_LROW;
            EPI_FOR_COLS { const size_t o = (size_t)row * 1024 + u.pn * 256 + EPI_LCOL; f32x4 p0, p1, g0, g1, h0, h1;
                unpack8(*(const u32x4*)(PO + o), p0, p1); unpack8(*(const u32x4*)(SGP + o), g0, g1); unpack8(*(const u32x4*)(SGM + o), h0, h1);
                *(u32x4*)(MG + o) = pack8(g0 * p0 + h0 * acc[ai][bj][m][0], g1 * p1 + h1 * acc[ai][bj][m][1]); } } } };
struct EpiRes { EPI_HEAD const float* R; float* Y;
    __device__ __forceinline__ void operator() EPI_SIG {
        EPI_FOR_ROWS { const int row = u.pm * 256 + EPI_LROW;
            EPI_FOR_COLS { const size_t o = (size_t)row * 1024 + u.pn * 256 + EPI_LCOL;
                *(f32x4*)(Y + o) = *(const f32x4*)(R + o) * ALPHA + acc[ai][bj][m][0]; *(f32x4*)(Y + o + 4) = *(const f32x4*)(R + o + 4) * ALPHA + acc[ai][bj][m][1]; } } } };
struct EpiUp { EPI_HEAD bf16_t* HID;
    __device__ __forceinline__ void operator() EPI_SIG {
        EPI_FOR_ROWS { const int row = u.pm * 256 + EPI_LROW;
            EPI_FOR_COLS { const size_t o = (size_t)row * 4096 + u.pn * 256 + EPI_LCOL; f32x4 v0 = acc[ai][bj][m][0], v1 = acc[ai][bj][m][1];
#pragma unroll
                for (int e = 0; e < 4; ++e) { const float a = fmaxf(v0[e], 0.f), b = fmaxf(v1[e], 0.f); v0[e] = a * a; v1[e] = b * b; }
                *(u32x4*)(HID + o) = pack8(v0, v1); } } } };

struct Ctx { LAS unsigned char* lds; int tid, lane, wave, gw, ngw, gtid, ngt; };

__device__ __forceinline__ void transpose_item(const float* src, int ld, int K, bf16_t* dst, int kb, int nb, LAS float* scr, int lane, float scale) {
    const int k0 = 64 * kb, n0 = 32 * nb;
#pragma unroll 8
    for (int i = 0; i < 32; ++i) { const int kk = 2 * i + (lane >> 5); scr[kk * 33 + (lane & 31)] = src[(size_t)(k0 + kk) * ld + n0 + (lane & 31)] * scale; }
    LDS_WAIT(); asm volatile("" ::: "memory");
    const int c = lane & 7;
#pragma unroll
    for (int j = 0; j < 4; ++j) { const int n = (lane >> 3) + 8 * j; const LAS float* s = scr + (8 * c) * 33 + n;
        u32x4 o; o.x = cvt_pk_bf16(s[0 * 33], s[1 * 33]); o.y = cvt_pk_bf16(s[2 * 33], s[3 * 33]); o.z = cvt_pk_bf16(s[4 * 33], s[5 * 33]); o.w = cvt_pk_bf16(s[6 * 33], s[7 * 33]);
        *(u32x4*)(dst + (size_t)(n0 + n) * K + k0 + 8 * c) = o; }
    LDS_WAIT(); asm volatile("" ::: "memory");
}
#define TR(SRC, LD, KK, NN, DST, SCALE) { const int nblk = (NN) / 32, nit = ((KK) / 64) * nblk; if (r < nit) { transpose_item(SRC, LD, KK, DST, r / nblk, r % nblk, scr, C.lane, SCALE); continue; } r -= nit; }
#define TR4(SRC, DST, SCALE) { if (r < 128) { const int g = r >> 5, rr = r & 31; transpose_item((SRC) + g * 65536, 256, 256, (DST) + g * 65536, rr >> 3, rr & 7, scr, C.lane, SCALE); continue; } r -= 128; }

__device__ __forceinline__ float log_sigmoid(float z) { return z < 0.f ? z - log1pf(expf(z)) : -log1pf(expf(-z)); }

struct Params { const float* in[20]; float* out; unsigned char* ws; };

__device__ __forceinline__ void phase0(const Ctx& C, const Params& p) {
    unsigned char* ws = p.ws; const float* w_in = p.in[1];
    LAS float* GWT = (LAS float*)C.lds;
    LAS float* scr = (LAS float*)(C.lds + 32768 + C.wave * 8448);
    for (int idx = C.tid; idx < 8192; idx += 512) { const int g = idx >> 10, k = idx & 1023; GWT[idx] = w_in[(size_t)k * INW + 4096 + g]; }
    __syncthreads();
    const float* x = p.in[0]; bf16_t* XB = (bf16_t*)(ws + SLOT0); float* IG = (float*)(ws + S_IG); float* LF = (float*)(ws + S_LF);
    for (int row = C.gw; row < T; row += C.ngw) {
        const f32x4* xr = (const f32x4*)(x + (size_t)row * 1024) + C.lane; f32x4 v[4]; float a8[8];
#pragma unroll
        for (int j = 0; j < 4; ++j) v[j] = xr[64 * j];
#pragma unroll
        for (int g = 0; g < 8; ++g) { float s = 0.f;
#pragma unroll
            for (int j = 0; j < 4; ++j) { const f32x4 w = *(const LAS f32x4*)(GWT + g * 1024 + 4 * (C.lane + 64 * j)); s += (v[j][0] * w[0] + v[j][1] * w[1]) + (v[j][2] * w[2] + v[j][3] * w[3]); }
            a8[g] = wave_sum(s); }
        u32x2* o8 = (u32x2*)(XB + (size_t)row * 1024) + C.lane;
#pragma unroll
        for (int j = 0; j < 4; ++j) { u32x2 w; w.x = cvt_pk_bf16(v[j][0], v[j][1]); w.y = cvt_pk_bf16(v[j][2], v[j][3]); o8[64 * j] = w; }
        if (C.lane == 0) {
#pragma unroll
            for (int h = 0; h < 4; ++h) { IG[(size_t)row * 4 + h] = a8[h] + p.in[6][h]; LF[(size_t)row * 4 + h] = log_sigmoid(a8[4 + h] + p.in[7][h]); } }
    }
    bf16_t* WCAT = (bf16_t*)(ws + W_CAT); bf16_t* WG = (bf16_t*)(ws + W_G);
    constexpr int NITEMS = 6 * 512 + 3 * 128 + 3 * 512;
    for (int it = C.gw; it < NITEMS; it += C.ngw) { int r = it;
        TR(w_in + 0, INW, 1024, 1024, WCAT, 1.f)
        TR(w_in + 1024, INW, 1024, 1024, WCAT + 1024 * 1024, 1.f)
        TR(w_in + 3072, INW, 1024, 1024, WCAT + 2 * 1024 * 1024, 1.f)
        TR(w_in + 2048, INW, 1024, 1024, (bf16_t*)(ws + W_VT), 1.f)
        TR(w_in + 4104, INW, 1024, 1024, WG, 1.f)
        TR(w_in + 5128, INW, 1024, 1024, WG + 1024 * 1024, 1.f)
        TR4(p.in[9], (bf16_t*)(ws + W_PW), 1.f)
        TR4(p.in[4], (bf16_t*)(ws + W_Q), 1.f)
        TR4(p.in[5], (bf16_t*)(ws + W_K), 0.0625f)
        TR(p.in[11], 1024, 1024, 1024, (bf16_t*)(ws + W_PP), 1.f)
        TR(p.in[12], 1024, 1024, 1024, (bf16_t*)(ws + W_M), 1.f)
        TR(p.in[13], 1024, 1024, 1024, (bf16_t*)(ws + W_O), 1.f)
    }
}
__device__ __forceinline__ void late_weights(const Ctx& C, const Params& p) {
    LAS float* scr = (LAS float*)(C.lds + 32768 + C.wave * 8448);
    constexpr int NITEMS = 2 * 2048;
    for (int it = C.gw; it < NITEMS; it += C.ngw) { int r = it;
        TR(p.in[16], 4096, 1024, 4096, (bf16_t*)(p.ws + W_UP), 1.f)
        TR(p.in[17], 1024, 4096, 1024, (bf16_t*)(p.ws + W_DN), 1.f)
    }
}

__device__ __forceinline__ void phase2(const Ctx& C, const Params& p, const bf16_t* U, const bf16_t* XM, bf16_t* PL, bf16_t* XC) {
    unsigned char* ws = p.ws;
    if (C.gw < 16) {
        const float* IG = (const float*)(ws + S_IG); const float* LF = (const float*)(ws + S_LF);
        float* WS = (float*)(ws + S_WS); float* EB = (float*)(ws + S_EB); float* KAP = (float*)(ws + S_KAP);
        const int bh = C.gw, b_ = bh >> 2, h = bh & 3, lane = C.lane; float mst = 0.f;
        for (int c = 0; c < 16; ++c) {
            const int s0 = c * 256 + lane * 4; float lf[4], ig[4];
#pragma unroll
            for (int e = 0; e < 4; ++e) { const size_t t = (size_t)b_ * 4096 + s0 + e; lf[e] = LF[t * 4 + h]; ig[e] = IG[t * 4 + h]; }
            const float p0 = lf[0], p1 = p0 + lf[1], p2 = p1 + lf[2], p3 = p2 + lf[3];
            float incl = p3;
#pragma unroll
            for (int o = 1; o < 64; o <<= 1) { const float y = __shfl_up(incl, o); if (lane >= o) incl += y; }
            const float off = incl - p3, bl = __shfl(incl, 63);
            float bb[4] = {off + p0, off + p1, off + p2, off + p3}; float a[4]; float am = -3.0e38f;
#pragma unroll
            for (int e = 0; e < 4; ++e) { a[e] = ig[e] - bb[e]; am = fmaxf(am, a[e]); }
            am = wave_max(am);
            const float G = fmaxf(mst, am), kap = expf(mst - G);
            f32x4 w;
#pragma unroll
            for (int e = 0; e < 4; ++e) { w[e] = expf(a[e] - G); EB[((size_t)b_ * 4096 + s0 + e) * 4 + h] = expf(-(bb[e] + G)); }
            *(f32x4*)(WS + (size_t)bh * 4096 + s0) = w;
            if (lane == 0) KAP[bh * 16 + c] = kap;
            mst = bl + G;
        }
    }
    const float* conv_w = p.in[2]; const float* conv_b = p.in[3];
    for (int idx = C.gtid; idx < 1024 * 128; idx += C.ngt) {
        const int cb = idx & 127, r = idx >> 7, t0 = r * 16, s0 = t0 & 4095, c0 = cb * 8;
        {
            const int w = 2 << (cb >> 5); const bf16_t* up = U + (size_t)t0 * 1024 + c0; bf16_t* op = PL + (size_t)t0 * 1024 + c0;
            f32x4 sa = {0.f, 0.f, 0.f, 0.f}, sb = {0.f, 0.f, 0.f, 0.f};
            for (int k = 1; k <= w; ++k) if (s0 - k >= 0) { f32x4 a, b; unpack8(*(const u32x4*)(up - (size_t)k * 1024), a, b); sa = sa + a; sb = sb + b; }
            for (int i = 0; i < 16; ++i) { f32x4 ca, cbv; unpack8(*(const u32x4*)(up + (size_t)i * 1024), ca, cbv); sa = sa + ca; sb = sb + cbv; const int s = s0 + i;
                if (s >= w) { f32x4 a, b; unpack8(*(const u32x4*)(up + (size_t)(i - w) * 1024), a, b); sa = sa - a; sb = sb - b; }
                const float inv = 1.f / (float)((s + 1) < w ? (s + 1) : w);
                *(u32x4*)(op + (size_t)i * 1024) = pack8(sa * inv - ca, sb * inv - cbv); }
        }
        {
            const bf16_t* xp = XM + (size_t)t0 * 1024 + c0; bf16_t* op = XC + (size_t)t0 * 1024 + c0;
            f32x4 w0a = *(const f32x4*)(conv_w + c0), w0b = *(const f32x4*)(conv_w + c0 + 4), w1a = *(const f32x4*)(conv_w + 1024 + c0), w1b = *(const f32x4*)(conv_w + 1024 + c0 + 4);
            f32x4 w2a = *(const f32x4*)(conv_w + 2048 + c0), w2b = *(const f32x4*)(conv_w + 2048 + c0 + 4), w3a = *(const f32x4*)(conv_w + 3072 + c0), w3b = *(const f32x4*)(conv_w + 3072 + c0 + 4);
            const f32x4 ba = *(const f32x4*)(conv_b + c0), bbv = *(const f32x4*)(conv_b + c0 + 4);
            f32x4 x0a = {0.f, 0.f, 0.f, 0.f}, x0b = x0a, x1a = x0a, x1b = x0a, x2a = x0a, x2b = x0a;
            if (s0 > 0) { unpack8(*(const u32x4*)(xp - 3 * 1024), x0a, x0b); unpack8(*(const u32x4*)(xp - 2 * 1024), x1a, x1b); unpack8(*(const u32x4*)(xp - 1024), x2a, x2b); }
            for (int i = 0; i < 16; ++i) { f32x4 x3a, x3b; unpack8(*(const u32x4*)(xp + (size_t)i * 1024), x3a, x3b);
                f32x4 ya = w0a * x0a + w1a * x1a + w2a * x2a + w3a * x3a + ba, yb = w0b * x0b + w1b * x1b + w2b * x2b + w3b * x3b + bbv;
                *(u32x4*)(op + (size_t)i * 1024) = pack8(ya * sigm4(ya), yb * sigm4(yb));
                x0a = x1a; x0b = x1b; x1a = x2a; x1b = x2b; x2a = x3a; x2b = x3b; }
        }
    }
}

__device__ __forceinline__ void dn_partials(const Ctx& C, const bf16_t* KW, float* DNP) {
    for (int it = C.gw; it < 1024; it += C.ngw) { const int L = it >> 2, kg = it & 3, bh = L >> 4, ch = L & 15;
        const bf16_t* kp = KW + ((size_t)((bh >> 2) * 4096 + ch * 256)) * 1024 + (bh & 3) * 256 + kg * 64 + C.lane; float s = 0.f;
#pragma unroll 8
        for (int t = 0; t < 256; ++t) s += __uint_as_float((unsigned)kp[(size_t)t * 1024] << 16);
        DNP[L * 256 + kg * 64 + C.lane] = s; }
}
__device__ __forceinline__ void state_scan(const Ctx& C, float* DC, const float* DNP, float* DN, const float* KAP) {
    for (int r = C.gw; r < 4096; r += C.ngw) { const int bh = r >> 8, vd = r & 255; f32x4 Cst = {0.f, 0.f, 0.f, 0.f};
        for (int c = 0; c < 16; ++c) { const float kap = KAP[bh * 16 + c]; float* rowp = DC + ((size_t)(bh * 16 + c) * 256 + vd) * 256;
            const f32x4 d = *((const f32x4*)rowp + C.lane);
            asm volatile("s_waitcnt vmcnt(0)" ::: "memory");
            const f32x4 Dv = Cst * kap; u32x2 w; w.x = cvt_pk_bf16(Dv[0], Dv[1]); w.y = cvt_pk_bf16(Dv[2], Dv[3]);
            *((u32x2*)rowp + C.lane) = w;
            asm volatile("" ::: "memory");
            Cst = Dv + d; } }
    for (int idx = C.gtid; idx < 4096; idx += C.ngt) { const int bh = idx >> 8, kd = idx & 255; float n = 0.f;
        for (int c = 0; c < 16; ++c) { const float Dn = KAP[bh * 16 + c] * n; DN[(bh * 16 + c) * 256 + kd] = Dn; n = Dn + DNP[(bh * 16 + c) * 256 + kd]; } }
}
__device__ __forceinline__ void head_norm(const Ctx& C, const Params& p, bf16_t* OUTP, const bf16_t* Q, const bf16_t* P, const bf16_t* SO) {
    const float* DN = (const float*)(p.ws + S_DN); const float* EB = (const float*)(p.ws + S_EB); const float* hng = p.in[8];
    for (int r = C.gw; r < T * 4; r += C.ngw) { const int t = r >> 2, h = r & 3, b_ = t >> 12, s = t & 4095, ch = s >> 8, i = s & 255, L = (b_ * 4 + h) * 16 + ch;
        const size_t off = (size_t)t * 1024 + h * 256 + 4 * C.lane;
        const u32x2 o2 = *(const u32x2*)(OUTP + off), q2 = *(const u32x2*)(Q + off), s2 = *(const u32x2*)(SO + off), p2 = *(const u32x2*)(P + ((size_t)L * 256 + i) * 256 + 4 * C.lane);
        const f32x4 dn = *(const f32x4*)(DN + L * 256 + 4 * C.lane), g = *(const f32x4*)(hng + h * 256 + 4 * C.lane);
        float den = (bf_lo(q2.x) * dn[0] + bf_hi(q2.x) * dn[1]) + (bf_lo(q2.y) * dn[2] + bf_hi(q2.y) * dn[3]) + (bf_lo(p2.x) + bf_hi(p2.x)) + (bf_lo(p2.y) + bf_hi(p2.y));
        den = wave_sum(den);
        const float inv = 1.f / fmaxf(fabsf(den), EB[(size_t)t * 4 + h]);
        f32x4 hv = {bf_lo(o2.x) * inv, bf_hi(o2.x) * inv, bf_lo(o2.y) * inv, bf_hi(o2.y) * inv};
        const float mu = wave_sum((hv[0] + hv[1]) + (hv[2] + hv[3])) * (1.f / 256.f);
        hv = hv - mu;
        const float var = wave_sum((hv[0] * hv[0] + hv[1] * hv[1]) + (hv[2] * hv[2] + hv[3] * hv[3])) * (1.f / 256.f);
        const float rstd = 1.f / sqrtf(var + HN_EPS);
        const f32x4 so = {bf_lo(s2.x), bf_hi(s2.x), bf_lo(s2.y), bf_hi(s2.y)};
        const f32x4 y = hv * rstd * g * so; u32x2 w; w.x = cvt_pk_bf16(y[0], y[1]); w.y = cvt_pk_bf16(y[2], y[3]);
        *(u32x2*)(OUTP + off) = w; }
}
__device__ __forceinline__ void ln_rows(const Ctx& C, const float* in, float* out, bf16_t* outb, const float* g, const float* b) {
    f32x4 gv[4], bv[4];
#pragma unroll
    for (int j = 0; j < 4; ++j) { gv[j] = *((const f32x4*)g + C.lane + 64 * j); bv[j] = *((const f32x4*)b + C.lane + 64 * j); }
    for (int row = C.gw; row < T; row += C.ngw) { const f32x4* xr = (const f32x4*)(in + (size_t)row * 1024) + C.lane; f32x4 v[4]; float s = 0.f;
#pragma unroll
        for (int j = 0; j < 4; ++j) { v[j] = xr[64 * j]; s += (v[j][0] + v[j][1]) + (v[j][2] + v[j][3]); }
        const float mean = wave_sum(s) * (1.f / 1024.f); float s2 = 0.f;
#pragma unroll
        for (int j = 0; j < 4; ++j) { v[j] = v[j] - mean; s2 += (v[j][0] * v[j][0] + v[j][1] * v[j][1]) + (v[j][2] * v[j][2] + v[j][3] * v[j][3]); }
        const float rstd = 1.f / sqrtf(wave_sum(s2) * (1.f / 1024.f) + LN_EPS);
        f32x4* orow = (f32x4*)(out + (size_t)row * 1024) + C.lane;
#pragma unroll
        for (int j = 0; j < 4; ++j) { const f32x4 y = v[j] * rstd * gv[j] + bv[j]; orow[64 * j] = y;
            if (outb) { u32x2 w; w.x = cvt_pk_bf16(y[0], y[1]); w.y = cvt_pk_bf16(y[2], y[3]); *((u32x2*)(outb + (size_t)row * 1024) + C.lane + 64 * j) = w; } } }
}

constexpr int LDS_BYTES = 131072;
__global__ void __launch_bounds__(512, 2) hybrid_fwd(Params p) {
    extern __shared__ __attribute__((aligned(16))) unsigned char lds_raw[];
    cg::grid_group grid = cg::this_grid();
    typedef const __attribute__((address_space(4))) Params* KP;
    KP pp = (KP)__builtin_amdgcn_kernarg_segment_ptr();
#define MKCTX() Ctx C; C.lds = (LAS unsigned char*)lds_raw; C.tid = threadIdx.x; C.lane = C.tid & 63; C.wave = __builtin_amdgcn_readfirstlane(C.tid >> 6); \
    const int G = gridDim.x, bx = blockIdx.x; C.gw = bx * 8 + C.wave; C.ngw = G * 8; C.gtid = bx * 512 + C.tid; C.ngt = G * 512; (void)G; (void)bx
#define PH_BEGIN() asm volatile("" : "+s"(pp)); Params p; _Pragma("unroll") for (int _i = 0; _i < 20; ++_i) p.in[_i] = pp->in[_i]; p.out = pp->out; p.ws = pp->ws; MKCTX(); unsigned char* ws = p.ws; unsigned char* ob = (unsigned char*)p.out; const char* cws = (const char*)ws; (void)ob; (void)cws
#define GSYNC() do { asm volatile("s_waitcnt vmcnt(0) lgkmcnt(0)" ::: "memory"); grid.sync(); } while (0)
#define SL(k) (ws + SLOT0 + (size_t)(k) * SLOT)
#define B_XB ((bf16_t*)SL(0))
#define B_U ((bf16_t*)SL(1))
#define B_XM ((bf16_t*)SL(2))
#define B_SO ((bf16_t*)SL(3))
#define B_VT ((bf16_t*)SL(4))
#define B_PL ((bf16_t*)SL(5))
#define B_XC ((bf16_t*)SL(6))
#define B_P2B ((bf16_t*)SL(1))
#define B_Q ((bf16_t*)SL(2))
#define B_KW ((bf16_t*)ob)
#define B_KT ((bf16_t*)(ob + SLOT))
#define B_DC ((float*)SL(5))
#define B_P ((bf16_t*)(ob + SLOT))
#define B_OUTP ((bf16_t*)ob)
#define B_PO ((bf16_t*)SL(2))
#define B_SGP ((bf16_t*)SL(3))
#define B_SGM ((bf16_t*)SL(4))
#define B_MG ((bf16_t*)SL(5))
#define B_Y (p.out)
#define B_X1 ((float*)SL(0))
#define B_X1B ((bf16_t*)SL(2))
#define B_HID ((bf16_t*)SL(3))

    { PH_BEGIN(); phase0(C, p); }
    GSYNC();
    { PH_BEGIN(); SchedMN S{(const char*)B_XB, cws + W_CAT, 64, 12, 768, G, bx, (size_t)256 * 2048, 0, (size_t)256 * 2048, 0}; EpiSec<2> E{B_U, SLOT / 2};
      pg8::gemm_phase<EpiSec<2>, SchedMN>(C.lds, 1024, 1024, 1024, S, E); }
    { PH_BEGIN(); SchedMN S{cws + W_VT, (const char*)B_XB, 4, 64, 256, G, bx, (size_t)256 * 2048, 0, (size_t)256 * 2048, 0}; EpiT<0> E{B_VT, nullptr};
      pg8::gemm_phase<EpiT<0>, SchedMN>(C.lds, 1024, 1024, 1024, S, E); }
    GSYNC();
    { PH_BEGIN(); phase2(C, p, B_U, B_XM, B_PL, B_XC); }
    GSYNC();
    { PH_BEGIN(); SchedMN S{(const char*)B_PL, cws + W_PW, 64, 4, 256, G, bx, (size_t)256 * 2048, 512, (size_t)256 * 512, 0}; EpiScale<0> E{B_P2B, p.in[10]};
      pg8::gemm_phase<EpiScale<0>, SchedMN>(C.lds, 256, 1024, 256, S, E); }
    { PH_BEGIN(); SchedMN S{(const char*)B_XC, cws + W_Q, 64, 4, 256, G, bx, (size_t)256 * 2048, 512, (size_t)256 * 512, 0}; EpiSec<9> E{B_Q, 256};
      pg8::gemm_phase<EpiSec<9>, SchedMN>(C.lds, 256, 1024, 256, S, E); }
    { PH_BEGIN(); SchedMN S{(const char*)B_XC, cws + W_K, 64, 4, 256, G, bx, (size_t)256 * 2048, 512, (size_t)256 * 512, 0}; EpiScale<1> E{B_KW, (const float*)(ws + S_WS)};
      pg8::gemm_phase<EpiScale<1>, SchedMN>(C.lds, 256, 1024, 256, S, E); }
    { PH_BEGIN(); SchedMN S{cws + W_K, (const char*)B_XC, 4, 64, 256, G, bx, (size_t)256 * 512, 0, (size_t)256 * 2048, 512}; EpiT<1> E{B_KT, (const float*)(ws + S_WS)};
      pg8::gemm_phase<EpiT<1>, SchedMN>(C.lds, 256, 256, 1024, S, E); }
    GSYNC();
    { PH_BEGIN(); Sched4 S{(const char*)B_VT, (const char*)B_KT, G, bx}; Epi4 E{B_DC};
      pg8::gemm_phase<Epi4, Sched4>(C.lds, 256, 4096, 4096, S, E); }
    { PH_BEGIN(); dn_partials(C, B_KW, (float*)(ws + S_DNP)); }
    GSYNC();
    { PH_BEGIN(); Sched5 S{(const char*)B_Q, (const char*)B_KW, G, bx}; Epi5 E{B_P};
      pg8::gemm_phase<Epi5, Sched5>(C.lds, 256, 1024, 1024, S, E); }
    { PH_BEGIN(); state_scan(C, B_DC, (const float*)(ws + S_DNP), (float*)(ws + S_DN), (const float*)(ws + S_KAP)); }
    GSYNC();
    { PH_BEGIN(); Sched6<0> S{(const char*)B_Q, (const char*)B_DC, G, bx}; Epi6<0> E{B_OUTP};
      pg8::gemm_phase<Epi6<0>, Sched6<0>>(C.lds, 256, 1024, 512, S, E); }
    { PH_BEGIN(); Sched6<1> S{(const char*)B_P, (const char*)B_VT, G, bx}; Epi6<1> E{B_OUTP};
      pg8::gemm_phase<Epi6<1>, Sched6<1>>(C.lds, 256, 256, 4096, S, E); }
    GSYNC();
    { PH_BEGIN(); head_norm(C, p, B_OUTP, B_Q, B_P, B_SO); }
    GSYNC();
    { PH_BEGIN(); SchedMN S{(const char*)B_P2B, cws + W_PP, 64, 4, 256, G, bx, (size_t)256 * 2048, 0, (size_t)256 * 2048, 0}; EpiSec<9> E{B_PO, 256};
      pg8::gemm_phase<EpiSec<9>, SchedMN>(C.lds, 1024, 1024, 1024, S, E); }
    { PH_BEGIN(); SchedMN S{(const char*)B_XB, cws + W_G, 64, 8, 512, G, bx, (size_t)256 * 2048, 0, (size_t)256 * 2048, 0}; EpiSec<0> E{B_SGP, SLOT / 2};
      pg8::gemm_phase<EpiSec<0>, SchedMN>(C.lds, 1024, 1024, 1024, S, E); }
    GSYNC();
    { PH_BEGIN(); SchedMN S{(const char*)B_OUTP, cws + W_M, 64, 4, 256, G, bx, (size_t)256 * 2048, 0, (size_t)256 * 2048, 0}; Epi9 E{B_PO, B_SGP, B_SGM, B_MG};
      pg8::gemm_phase<Epi9, SchedMN>(C.lds, 1024, 1024, 1024, S, E); }
    GSYNC();
    { PH_BEGIN(); SchedMN S{(const char*)B_MG, cws + W_O, 64, 4, 256, G, bx, (size_t)256 * 2048, 0, (size_t)256 * 2048, 0}; EpiRes E{p.in[0], B_Y};
      pg8::gemm_phase<EpiRes, SchedMN>(C.lds, 1024, 1024, 1024, S, E); }
    GSYNC();
    { PH_BEGIN(); ln_rows(C, B_Y, B_X1, B_X1B, p.in[14], p.in[15]); late_weights(C, p); }
    GSYNC();
    { PH_BEGIN(); SchedMN S{(const char*)B_X1B, cws + W_UP, 64, 16, 1024, G, bx, (size_t)256 * 2048, 0, (size_t)256 * 2048, 0}; EpiUp E{B_HID};
      pg8::gemm_phase<EpiUp, SchedMN>(C.lds, 1024, 1024, 1024, S, E); }
    GSYNC();
    { PH_BEGIN(); SchedMN S{(const char*)B_HID, cws + W_DN, 64, 4, 256, G, bx, (size_t)256 * 8192, 0, (size_t)256 * 8192, 0}; EpiRes E{B_X1, B_Y};
      pg8::gemm_phase<EpiRes, SchedMN>(C.lds, 4096, 4096, 4096, S, E); }
    GSYNC();
    { PH_BEGIN(); ln_rows(C, B_Y, B_Y, nullptr, p.in[18], p.in[19]); }
}

extern "C" void kernel_launch(void* const* d_in, const int* in_sizes, int n_in, void* d_out, int out_size, void* d_ws, size_t ws_size, hipStream_t stream) {
    static int grid = 0;
    if (grid == 0) {
        if (n_in != 20 || in_sizes[0] != T * DM || out_size != T * DM || ws_size < WS_NEED) { fprintf(stderr, "kernel_launch: unexpected shapes (n_in %d, in0 %d, out %d, ws %zu)\n", n_in, n_in > 0 ? in_sizes[0] : -1, out_size, ws_size); grid = -1; return; }
        int dev = 0, cus = 0, per_cu = 0;
        hipGetDevice(&dev); hipDeviceGetAttribute(&cus, hipDeviceAttributeMultiprocessorCount, dev);
        hipFuncSetAttribute((const void*)hybrid_fwd, hipFuncAttributeMaxDynamicSharedMemorySize, LDS_BYTES);
        hipOccupancyMaxActiveBlocksPerMultiprocessor(&per_cu, (const void*)hybrid_fwd, 512, LDS_BYTES);
        if (per_cu < 1) per_cu = 1;
        grid = cus * 1;
        (void)hipGetLastError();
    }
    if (grid < 0) return;
    Params p{};
    for (int i = 0; i < 20; ++i) p.in[i] = (const float*)d_in[i];
    p.out = (float*)d_out; p.ws = (unsigned char*)d_ws;
    void* args[] = {&p};
    hipError_t e = hipLaunchCooperativeKernel((const void*)hybrid_fwd, dim3(grid), dim3(512), args, LDS_BYTES, stream);
    if (e != hipSuccess) fprintf(stderr, "cooperative launch failed: %s (grid %d)\n", hipGetErrorString(e), grid);
}
```

```cpp
#include <hip/hip_runtime.h>
#include <hip/hip_cooperative_groups.h>
#include <cstdio>
#include <cstdint>
namespace cg = cooperative_groups;

namespace pg8 {
#define PG8_LAS __attribute__((address_space(3)))
typedef unsigned short bf16_t;
typedef short bf16x8 __attribute__((ext_vector_type(8)));
typedef float f32x4 __attribute__((ext_vector_type(4)));
typedef unsigned u32x4 __attribute__((ext_vector_type(4)));
constexpr int BM = 256, BK = 64, HALF = 128, HTB = HALF * BK * 2  , STAGE_BYTES = 8 * HTB;

__host__ __device__ __forceinline__ int lds_byte(int r, int c) { const int st = (r >> 4) * 2 + (c >> 5), rr = r & 15, cc = c & 31, ob = rr * 64 + cc * 2; return st * 1024 + (ob ^ (((ob >> 9) & 1) << 5)); }
__host__ __device__ __forceinline__ void stage_rc(int b, int& R, int& C) { const int st = b / 1024, sb = b % 1024, swz = sb ^ (((sb >> 9) & 1) << 5); R = (st >> 1) * 16 + swz / 64; C = (st & 1) * 32 + (swz % 64) / 2; }
__host__ __device__ __forceinline__ int perm32(int rho) { const int n = rho >> 4, i = rho & 15; return 8 * (i >> 2) + 4 * n + (i & 3); }

struct Unit { int pm, pn, kind; const char* a; const char* b; };

__device__ __forceinline__ void tmpl_decode(int wgid, int nM, int nN, int& pm, int& pn) {
    const int nwg = nM * nN;
    { const int q = nwg / 8, r = nwg % 8, xcd = wgid % 8, off = wgid / 8; wgid = (xcd < r ? xcd * (q + 1) : r * (q + 1) + (xcd - r) * q) + off; }
    const int nig = 8 * nN, gid = wgid / nig, fm = gid * 8, gsz = (nM - fm) < 8 ? (nM - fm) : 8;
    pm = fm + ((wgid % nig) % gsz); pn = (wgid % nig) / gsz;
}

template <class Epi, class Sched, bool ALIGN_EPI = true, bool SP2 = true>
__device__ __forceinline__ void gemm_phase(PG8_LAS unsigned char* lds, const int K, const int lda, const int ldb, const Sched& S, const Epi& E) {
    int tid_ = threadIdx.x; asm volatile("" : "+v"(tid_));
    const int tid = tid_, wid = __builtin_amdgcn_readfirstlane(tid >> 6), lane = tid & 63, wr = wid >> 2, wc = wid & 3, fr = lane & 15, fq = lane >> 4;
    int nt = K / BK; asm volatile("" : "+s"(nt));
    unsigned voffA[2], voffB[2];
#pragma unroll
    for (int i = 0; i < 2; ++i) { int R, C; stage_rc(tid * 16 + i * 8192, R, C); const int Rb = Epi::PERM ? ((R & ~31) + perm32(R & 31)) : R;
        voffA[i] = (unsigned)(R * lda + C) * 2u; voffB[i] = (unsigned)(Rb * ldb + C) * 2u; }
    const size_t kstep = (size_t)(BK * 2);
    const size_t hstepA = (size_t)HALF * lda * 2, hstepB = (size_t)HALF * ldb * 2;
    const unsigned ldsw = (unsigned)wid * 1024u;
    const int aoff = lds_byte(wr * 64 + fr, fq * 8), boff = lds_byte(wc * 32 + fr, fq * 8);
#define PG8_SA(b, h) (((b) * 2 + (h)) * HTB)
#define PG8_SB(b, h) ((4 + (b) * 2 + (h)) * HTB)
#define PG8_STAGE(bufoff, gbase, voff) do { _Pragma("unroll") for (int _i = 0; _i < 2; ++_i) \
        __builtin_amdgcn_global_load_lds((const unsigned*)((const char*)(gbase) + (voff)[_i]), (PG8_LAS unsigned*)(lds + (bufoff) + ldsw + _i * 8192), 16, 0, 0); } while (0)
#define PG8_LDA(dst, b, h) do { _Pragma("unroll") for (int m = 0; m < 4; ++m) _Pragma("unroll") for (int k = 0; k < 2; ++k) dst[m][k] = *(const PG8_LAS bf16x8*)(lds + PG8_SA(b, h) + aoff + m * 2048 + k * 1024); } while (0)
#define PG8_LDB(dst, b, h) do { _Pragma("unroll") for (int n = 0; n < 2; ++n) _Pragma("unroll") for (int k = 0; k < 2; ++k) dst[n][k] = *(const PG8_LAS bf16x8*)(lds + PG8_SB(b, h) + boff + n * 2048 + k * 1024); } while (0)
#define PG8_MMA(ai, bj, At, Bt) do { __builtin_amdgcn_s_setprio(1); _Pragma("unroll") for (int m = 0; m < 4; ++m) _Pragma("unroll") for (int n = 0; n < 2; ++n) _Pragma("unroll") for (int k = 0; k < 2; ++k) \
        acc[ai][bj][m][n] = __builtin_amdgcn_mfma_f32_16x16x32_bf16(Bt[n][k], At[m][k], acc[ai][bj][m][n], 0, 0, 0); __builtin_amdgcn_s_setprio(0); } while (0)
#define PG8_WAIT_V(n) asm volatile("s_waitcnt vmcnt(" #n ")" ::: "memory")
#define PG8_WAIT_L(n) asm volatile("s_waitcnt lgkmcnt(" #n ")" ::: "memory")
#define PG8_BAR __builtin_amdgcn_s_barrier()
#define PG8_SCHED __builtin_amdgcn_sched_barrier(0)
    Unit cur, nxt; int ui = 0;
    if (!S.next(0, cur)) return;
    f32x4 acc[2][2][4][2];
#pragma unroll
    for (int a = 0; a < 2; ++a)
#pragma unroll
        for (int b = 0; b < 2; ++b)
#pragma unroll
            for (int m = 0; m < 4; ++m)
#pragma unroll
                for (int n = 0; n < 2; ++n) acc[a][b][m][n] = (f32x4){0.f, 0.f, 0.f, 0.f};
    bf16x8 At[4][2], B0[2][2], B1[2][2];
    const char* cA = cur.a; const char* cB = cur.b;
    if constexpr (SP2) {
        PG8_STAGE(PG8_SB(0, 0), cB, voffB); PG8_STAGE(PG8_SB(0, 1), cB + hstepB, voffB); PG8_STAGE(PG8_SA(0, 0), cA, voffA); PG8_STAGE(PG8_SA(0, 1), cA + hstepA, voffA);
        if (wr == 1) PG8_BAR;
        PG8_WAIT_V(2); PG8_BAR;
        PG8_STAGE(PG8_SB(1, 0), cB + kstep, voffB); PG8_STAGE(PG8_SA(1, 0), cA + kstep, voffA); PG8_STAGE(PG8_SB(1, 1), cB + hstepB + kstep, voffB);
        PG8_WAIT_V(6); PG8_BAR;
    } else {
        PG8_STAGE(PG8_SB(0, 0), cB, voffB); PG8_STAGE(PG8_SA(0, 0), cA, voffA); PG8_STAGE(PG8_SB(0, 1), cB + hstepB, voffB); PG8_STAGE(PG8_SA(0, 1), cA + hstepA, voffA);
        if (wr == 1) PG8_BAR;
        PG8_WAIT_V(4); PG8_BAR;
        PG8_STAGE(PG8_SB(1, 0), cB + kstep, voffB); PG8_STAGE(PG8_SA(1, 0), cA + kstep, voffA); PG8_STAGE(PG8_SB(1, 1), cB + hstepB + kstep, voffB);
        PG8_WAIT_V(6); PG8_BAR;
    }
    for (;;) {
        const bool has_next = S.next(ui + 1, nxt);
        const char* nA = has_next ? nxt.a : cA; const char* nB = has_next ? nxt.b : cB;
#pragma nounroll
        for (int t = 0; t < nt; t += 2) {
            const bool last = (t == nt - 2);
            const char* a1 = cA + (size_t)(t + 1) * kstep;
            const char* a2 = last ? nA : cA + (size_t)(t + 2) * kstep; const char* b2 = last ? nB : cB + (size_t)(t + 2) * kstep;
            const char* a3 = a2 + kstep; const char* b3 = b2 + kstep;
            if constexpr (SP2) {
            PG8_LDB(B0, 0, 0); PG8_LDB(B1, 0, 1); PG8_SCHED; PG8_LDA(At, 0, 0); PG8_STAGE(PG8_SA(1, 1), a1 + hstepA, voffA);
            PG8_WAIT_V(8); PG8_WAIT_L(0); PG8_BAR; PG8_MMA(0, 0, At, B0); PG8_MMA(0, 1, At, B1); PG8_BAR; PG8_SCHED;
            PG8_LDA(At, 0, 1); PG8_STAGE(PG8_SB(0, 0), b2, voffB); PG8_STAGE(PG8_SB(0, 1), b2 + hstepB, voffB); PG8_STAGE(PG8_SA(0, 0), a2, voffA);
            PG8_WAIT_V(8); PG8_WAIT_L(0); PG8_BAR; PG8_MMA(1, 0, At, B0); PG8_MMA(1, 1, At, B1); PG8_BAR; PG8_SCHED;
            PG8_LDB(B0, 1, 0); PG8_LDB(B1, 1, 1); PG8_SCHED; PG8_LDA(At, 1, 0); PG8_STAGE(PG8_SA(0, 1), a2 + hstepA, voffA);
            PG8_WAIT_V(8); PG8_WAIT_L(0); PG8_BAR; PG8_MMA(0, 0, At, B0); PG8_MMA(0, 1, At, B1); PG8_BAR; PG8_SCHED;
            PG8_LDA(At, 1, 1); PG8_STAGE(PG8_SB(1, 0), b3, voffB); PG8_STAGE(PG8_SB(1, 1), b3 + hstepB, voffB); PG8_STAGE(PG8_SA(1, 0), a3, voffA);
            PG8_WAIT_V(8); PG8_WAIT_L(0); PG8_BAR; PG8_MMA(1, 0, At, B0); PG8_MMA(1, 1, At, B1); PG8_BAR; PG8_SCHED;
            } else {
            PG8_LDB(B0, 0, 0); PG8_SCHED; PG8_LDA(At, 0, 0); PG8_STAGE(PG8_SA(1, 1), a1 + hstepA, voffA);
            PG8_WAIT_L(8); PG8_BAR; PG8_WAIT_L(0); PG8_MMA(0, 0, At, B0); PG8_BAR; PG8_SCHED;
            PG8_LDB(B1, 0, 1); PG8_STAGE(PG8_SB(0, 0), b2, voffB);
            PG8_BAR; PG8_WAIT_L(0); PG8_MMA(0, 1, At, B1); PG8_BAR;
            PG8_LDA(At, 0, 1); PG8_STAGE(PG8_SA(0, 0), a2, voffA);
            PG8_BAR; PG8_WAIT_L(0); PG8_MMA(1, 0, At, B0); PG8_BAR; PG8_SCHED;
            PG8_STAGE(PG8_SB(0, 1), b2 + hstepB, voffB);
            PG8_WAIT_V(6); PG8_BAR; PG8_MMA(1, 1, At, B1); PG8_BAR;
            PG8_LDB(B0, 1, 0); PG8_SCHED; PG8_LDA(At, 1, 0); PG8_STAGE(PG8_SA(0, 1), a2 + hstepA, voffA);
            PG8_WAIT_L(8); PG8_BAR; PG8_WAIT_L(0); PG8_MMA(0, 0, At, B0); PG8_BAR; PG8_SCHED;
            PG8_LDB(B1, 1, 1); PG8_STAGE(PG8_SB(1, 0), b3, voffB);
            PG8_BAR; PG8_WAIT_L(0); PG8_MMA(0, 1, At, B1); PG8_BAR;
            PG8_LDA(At, 1, 1); PG8_STAGE(PG8_SA(1, 0), a3, voffA);
            PG8_BAR; PG8_WAIT_L(0); PG8_MMA(1, 0, At, B0); PG8_BAR; PG8_SCHED;
            PG8_STAGE(PG8_SB(1, 1), b3 + hstepB, voffB);
            PG8_WAIT_V(6); PG8_BAR; PG8_MMA(1, 1, At, B1); PG8_BAR;
            }
        }
        if constexpr (ALIGN_EPI) { if (wr == 0) PG8_BAR; }
        if constexpr (!Epi::AFTER_DRAIN) { E(acc, cur, wr, wc, fr, fq); }
        if (!has_next) break;
#pragma unroll
        for (int a = 0; a < 2; ++a)
#pragma unroll
            for (int b = 0; b < 2; ++b)
#pragma unroll
                for (int m = 0; m < 4; ++m)
#pragma unroll
                    for (int n = 0; n < 2; ++n) acc[a][b][m][n] = (f32x4){0.f, 0.f, 0.f, 0.f};
        cur = nxt; cA = nA; cB = nB; ++ui;
        if constexpr (ALIGN_EPI) { if (wr == 1) PG8_BAR; }
    }
    PG8_WAIT_V(0);
    if constexpr (!ALIGN_EPI) { if (wr == 0) PG8_BAR; }
    PG8_BAR;
#undef PG8_SA
#undef PG8_SB
#undef PG8_STAGE
#undef PG8_LDA
#undef PG8_LDB
#undef PG8_MMA
#undef PG8_WAIT_V
#undef PG8_WAIT_L
#undef PG8_BAR
#undef PG8_SCHED
}
}

using pg8::Unit; using pg8::bf16_t; using pg8::f32x4; using pg8::u32x4; using pg8::tmpl_decode;
#define LAS __attribute__((address_space(3)))
typedef unsigned u32x2 __attribute__((ext_vector_type(2)));
#define LDS_WAIT() asm volatile("s_waitcnt lgkmcnt(0)" ::: "memory")

constexpr int T = 16384, DM = 1024, SEQ = 4096, FF = 4096, INW = 6152;
constexpr float ALPHA = 1.18920711500272f;
constexpr float LN_EPS = 1e-5f, HN_EPS = 1e-6f;
constexpr size_t MiB = 1u << 20;
constexpr size_t W_CAT = 0, W_G = 6 * MiB, W_VT = 10 * MiB, W_PP = 12 * MiB, W_M = 14 * MiB, W_O = 16 * MiB, W_PW = 18 * MiB, W_Q = 18 * MiB + 512 * 1024, W_K = 19 * MiB;
constexpr size_t W_UP = 0, W_DN = 8 * MiB;
constexpr size_t S_IG = 24 * MiB, S_LF = S_IG + 256 * 1024, S_WS = S_LF + 256 * 1024, S_EB = S_WS + 256 * 1024, S_DNP = 25 * MiB, S_DN = S_DNP + 256 * 1024, S_KAP = S_DN + 256 * 1024;
constexpr size_t SLOT0 = 32 * MiB, SLOT = 32 * MiB;
constexpr size_t WS_NEED = 256 * MiB;

__device__ __forceinline__ unsigned cvt_pk_bf16(float lo, float hi) { unsigned r; asm("v_cvt_pk_bf16_f32 %0, %1, %2" : "=v"(r) : "v"(lo), "v"(hi)); return r; }
__device__ __forceinline__ float bf_lo(unsigned w) { return __uint_as_float(w << 16); }
__device__ __forceinline__ float bf_hi(unsigned w) { return __uint_as_float(w & 0xffff0000u); }
__device__ __forceinline__ u32x4 pack8(f32x4 a, f32x4 b) { u32x4 w; w.x = cvt_pk_bf16(a[0], a[1]); w.y = cvt_pk_bf16(a[2], a[3]); w.z = cvt_pk_bf16(b[0], b[1]); w.w = cvt_pk_bf16(b[2], b[3]); return w; }
__device__ __forceinline__ void unpack8(u32x4 w, f32x4& a, f32x4& b) { a[0] = bf_lo(w.x); a[1] = bf_hi(w.x); a[2] = bf_lo(w.y); a[3] = bf_hi(w.y); b[0] = bf_lo(w.z); b[1] = bf_hi(w.z); b[2] = bf_lo(w.w); b[3] = bf_hi(w.w); }
__device__ __forceinline__ float sigm(float x) { return __builtin_amdgcn_rcpf(1.f + __expf(-x)); }
__device__ __forceinline__ f32x4 sigm4(f32x4 v) { f32x4 r; r[0] = sigm(v[0]); r[1] = sigm(v[1]); r[2] = sigm(v[2]); r[3] = sigm(v[3]); return r; }
__device__ __forceinline__ float wave_sum(float v) {
#pragma unroll
    for (int o = 1; o < 64; o <<= 1) v += __shfl_xor(v, o);
    return v;
}
__device__ __forceinline__ float wave_max(float v) {
#pragma unroll
    for (int o = 1; o < 64; o <<= 1) v = fmaxf(v, __shfl_xor(v, o));
    return v;
}

#define EPI_HEAD static constexpr bool PERM = true, AFTER_DRAIN = false;
#define EPI_SIG (const f32x4 (&acc)[2][2][4][2], const Unit& u, int wr, int wc, int fr, int fq) const
#define EPI_FOR_ROWS _Pragma("unroll") for (int ai = 0; ai < 2; ++ai) _Pragma("unroll") for (int m = 0; m < 4; ++m)
#define EPI_FOR_COLS _Pragma("unroll") for (int bj = 0; bj < 2; ++bj)
#define EPI_LROW (ai * 128 + wr * 64 + m * 16 + fr)
#define EPI_LCOL (bj * 128 + wc * 32 + 8 * fq)

struct SchedMN { const char *A, *B; int nM, nN, nU, G, c; size_t sa, apn, sb, bpm;
    __device__ __forceinline__ bool next(int i, Unit& u) const { const int L = i * G + c; if (L >= nU) return false;
        tmpl_decode(L, nM, nN, u.pm, u.pn); u.kind = 0; u.a = A + (size_t)u.pm * sa + (size_t)u.pn * apn; u.b = B + (size_t)u.pn * sb + (size_t)u.pm * bpm; return true; } };
template <int SIGSEC> struct EpiSec { EPI_HEAD bf16_t* base; size_t secstride;
    __device__ __forceinline__ void operator() EPI_SIG {
        const int sec = u.pn >> 2; bf16_t* bp = base + (size_t)sec * secstride + (u.pn & 3) * 256;
        EPI_FOR_ROWS { const int row = u.pm * 256 + EPI_LROW;
            EPI_FOR_COLS { f32x4 v0 = acc[ai][bj][m][0], v1 = acc[ai][bj][m][1];
                if (sec >= SIGSEC) { v0 = sigm4(v0); v1 = sigm4(v1); }
                *(u32x4*)(bp + (size_t)row * 1024 + EPI_LCOL) = pack8(v0, v1); } } } };
template <int WEIGHT> struct EpiT { EPI_HEAD bf16_t* DST; const float* WS;
    __device__ __forceinline__ void operator() EPI_SIG {
        EPI_FOR_ROWS { const int rowl = u.pm * 256 + EPI_LROW;
            EPI_FOR_COLS { const int tok = u.pn * 256 + EPI_LCOL, b_ = tok >> 12, s = tok & 4095; f32x4 v0 = acc[ai][bj][m][0], v1 = acc[ai][bj][m][1];
                if (WEIGHT) { const float* wp = WS + (size_t)(b_ * 4 + u.pm) * 4096 + s; v0 = v0 * *(const f32x4*)wp; v1 = v1 * *(const f32x4*)(wp + 4); }
                *(u32x4*)(DST + ((size_t)(b_ * 1024 + rowl)) * 4096 + s) = pack8(v0, v1); } } } };
template <int MODE> struct EpiScale { EPI_HEAD bf16_t* DST; const float* sc;
    __device__ __forceinline__ void operator() EPI_SIG {
        EPI_FOR_ROWS { const int row = u.pm * 256 + EPI_LROW; float rs = 1.f;
            if (MODE == 1) rs = sc[(size_t)((row >> 12) * 4 + u.pn) * 4096 + (row & 4095)];
            EPI_FOR_COLS { const int col = u.pn * 256 + EPI_LCOL; f32x4 v0 = acc[ai][bj][m][0], v1 = acc[ai][bj][m][1];
                if (MODE == 0) { v0 = v0 * *(const f32x4*)(sc + col); v1 = v1 * *(const f32x4*)(sc + col + 4); }
                else { v0 = v0 * rs; v1 = v1 * rs; }
                *(u32x4*)(DST + (size_t)row * 1024 + col) = pack8(v0, v1); } } } };
struct Sched4 { const char *VT, *KT; int G, c;
    __device__ __forceinline__ bool next(int i, Unit& u) const { const int L = i * G + c; if (L >= 256) return false;
        u.pm = L; u.pn = 0; u.kind = 0; const size_t off = ((size_t)(L >> 4) * 256 * 4096 + (size_t)(L & 15) * 256) * 2; u.a = VT + off; u.b = KT + off; return true; } };
struct Epi4 { EPI_HEAD float* DC;
    __device__ __forceinline__ void operator() EPI_SIG {
        EPI_FOR_ROWS { float* rp = DC + ((size_t)u.pm * 256 + EPI_LROW) * 256;
            EPI_FOR_COLS { *(f32x4*)(rp + EPI_LCOL) = acc[ai][bj][m][0]; *(f32x4*)(rp + EPI_LCOL + 4) = acc[ai][bj][m][1]; } } } };
struct Sched5 { const char *Q, *KW; int G, c;
    __device__ __forceinline__ bool next(int i, Unit& u) const { const int L = i * G + c; if (L >= 256) return false;
        u.pm = L; u.pn = 0; u.kind = 0; const int bh = L >> 4, ch = L & 15; const size_t off = ((size_t)((bh >> 2) * 4096 + ch * 256) * 1024 + (size_t)(bh & 3) * 256) * 2; u.a = Q + off; u.b = KW + off; return true; } };
struct Epi5 { EPI_HEAD bf16_t* P;
    __device__ __forceinline__ void operator() EPI_SIG {
        asm volatile("" : "+v"(fr));
        EPI_FOR_ROWS { const int i = EPI_LROW; bf16_t* rp = P + ((size_t)u.pm * 256 + i) * 256;
            EPI_FOR_COLS { const int j0 = EPI_LCOL; f32x4 v0 = acc[ai][bj][m][0], v1 = acc[ai][bj][m][1];
#pragma unroll
                for (int e = 0; e < 4; ++e) { const int lim = i - j0; v0[e] = (lim >= e) ? v0[e] : 0.f; v1[e] = (lim >= e + 4) ? v1[e] : 0.f; }
                *(u32x4*)(rp + j0) = pack8(v0, v1); __builtin_amdgcn_sched_barrier(0); } } } };
template <int MODE> struct Sched6 { const char *A, *B; int G, c;
    __device__ __forceinline__ bool next(int i, Unit& u) const { const int L = i * G + c; if (L >= 256) return false;
        const int bh = L >> 4, ch = L & 15; u.pm = (bh >> 2) * 16 + ch; u.pn = bh & 3; u.kind = 0;
        if (MODE == 0) { u.a = A + ((size_t)((bh >> 2) * 4096 + ch * 256) * 1024 + (size_t)(bh & 3) * 256) * 2; u.b = B + (size_t)L * 256 * 1024; }
        else { u.a = A + (size_t)L * 65536 * 2; u.b = B + ((size_t)bh * 256 * 4096 + (size_t)ch * 256) * 2; }
        return true; } };
template <int ADD> struct Epi6 { EPI_HEAD bf16_t* OUTP;
    __device__ __forceinline__ void operator() EPI_SIG {
        EPI_FOR_ROWS { const int row = u.pm * 256 + EPI_LROW;
            EPI_FOR_COLS { const int col = u.pn * 256 + EPI_LCOL; f32x4 v0 = acc[ai][bj][m][0], v1 = acc[ai][bj][m][1]; u32x4* p = (u32x4*)(OUTP + (size_t)row * 1024 + col);
                if (ADD) { f32x4 o0, o1; unpack8(*p, o0, o1); v0 = v0 + o0; v1 = v1 + o1; }
                *p = pack8(v0, v1); } } } };
struct Epi9 { EPI_HEAD const bf16_t *PO, *SGP, *SGM; bf16_t* MG;
    __device__ __forceinline__ void operator() EPI_SIG {
        EPI_FOR_ROWS { const int row = u.pm * 256 + EPI_LROW;
            EPI_FOR_COLS { const size_t o = (size_t)row * 1024 + u.pn * 256 + EPI_LCOL; f32x4 p0, p1, g0, g1, h0, h1;
                unpack8(*(const u32x4*)(PO + o), p0, p1); unpack8(*(const u32x4*)(SGP + o), g0, g1); unpack8(*(const u32x4*)(SGM + o), h0, h1);
                *(u32x4*)(MG + o) = pack8(g0 * p0 + h0 * acc[ai][bj][m][0], g1 * p1 + h1 * acc[ai][bj][m][1]); } } } };
struct EpiRes { EPI_HEAD const float* R; float* Y;
    __device__ __forceinline__ void operator() EPI_SIG {
        EPI_FOR_ROWS { const int row = u.pm * 256 + EPI_LROW;
            EPI_FOR_COLS { const size_t o = (size_t)row * 1024 + u.pn * 256 + EPI_LCOL;
                *(f32x4*)(Y + o) = *(const f32x4*)(R + o) * ALPHA + acc[ai][bj][m][0]; *(f32x4*)(Y + o + 4) = *(const f32x4*)(R + o + 4) * ALPHA + acc[ai][bj][m][1]; } } } };
struct EpiUp { EPI_HEAD bf16_t* HID;
    __device__ __forceinline__ void operator() EPI_SIG {
        EPI_FOR_ROWS { const int row = u.pm * 256 + EPI_LROW;
            EPI_FOR_COLS { const size_t o = (size_t)row * 4096 + u.pn * 256 + EPI_LCOL; f32x4 v0 = acc[ai][bj][m][0], v1 = acc[ai][bj][m][1];
#pragma unroll
                for (int e = 0; e < 4; ++e) { const float a = fmaxf(v0[e], 0.f), b = fmaxf(v1[e], 0.f); v0[e] = a * a; v1[e] = b * b; }
                *(u32x4*)(HID + o) = pack8(v0, v1); } } } };

struct Ctx { LAS unsigned char* lds; int tid, lane, wave, gw, ngw, gtid, ngt; };

__device__ __forceinline__ void transpose_item(const float* src, int ld, int K, bf16_t* dst, int kb, int nb, LAS float* scr, int lane, float scale) {
    const int k0 = 64 * kb, n0 = 32 * nb;
#pragma unroll 8
    for (int i = 0; i < 32; ++i) { const int kk = 2 * i + (lane >> 5); scr[kk * 33 + (lane & 31)] = src[(size_t)(k0 + kk) * ld + n0 + (lane & 31)] * scale; }
    LDS_WAIT(); asm volatile("" ::: "memory");
    const int c = lane & 7;
#pragma unroll
    for (int j = 0; j < 4; ++j) { const int n = (lane >> 3) + 8 * j; const LAS float* s = scr + (8 * c) * 33 + n;
        u32x4 o; o.x = cvt_pk_bf16(s[0 * 33], s[1 * 33]); o.y = cvt_pk_bf16(s[2 * 33], s[3 * 33]); o.z = cvt_pk_bf16(s[4 * 33], s[5 * 33]); o.w = cvt_pk_bf16(s[6 * 33], s[7 * 33]);
        *(u32x4*)(dst + (size_t)(n0 + n) * K + k0 + 8 * c) = o; }
    LDS_WAIT(); asm volatile("" ::: "memory");
}
#define TR(SRC, LD, KK, NN, DST, SCALE) { const int nblk = (NN) / 32, nit = ((KK) / 64) * nblk; if (r < nit) { transpose_item(SRC, LD, KK, DST, r / nblk, r % nblk, scr, C.lane, SCALE); continue; } r -= nit; }
#define TR4(SRC, DST, SCALE) { if (r < 128) { const int g = r >> 5, rr = r & 31; transpose_item((SRC) + g * 65536, 256, 256, (DST) + g * 65536, rr >> 3, rr & 7, scr, C.lane, SCALE); continue; } r -= 128; }

__device__ __forceinline__ float log_sigmoid(float z) { return z < 0.f ? z - log1pf(expf(z)) : -log1pf(expf(-z)); }

struct Params { const float* in[20]; float* out; unsigned char* ws; };

__device__ __forceinline__ void phase0(const Ctx& C, const Params& p) {
    unsigned char* ws = p.ws; const float* w_in = p.in[1];
    LAS float* GWT = (LAS float*)C.lds;
    LAS float* scr = (LAS float*)(C.lds + 32768 + C.wave * 8448);
    for (int idx = C.tid; idx < 8192; idx += 512) { const int g = idx >> 10, k = idx & 1023; GWT[idx] = w_in[(size_t)k * INW + 4096 + g]; }
    __syncthreads();
    const float* x = p.in[0]; bf16_t* XB = (bf16_t*)(ws + SLOT0); float* IG = (float*)(ws + S_IG); float* LF = (float*)(ws + S_LF);
    for (int row = C.gw; row < T; row += C.ngw) {
        const f32x4* xr = (const f32x4*)(x + (size_t)row * 1024) + C.lane; f32x4 v[4]; float a8[8];
#pragma unroll
        for (int j = 0; j < 4; ++j) v[j] = xr[64 * j];
#pragma unroll
        for (int g = 0; g < 8; ++g) { float s = 0.f;
#pragma unroll
            for (int j = 0; j < 4; ++j) { const f32x4 w = *(const LAS f32x4*)(GWT + g * 1024 + 4 * (C.lane + 64 * j)); s += (v[j][0] * w[0] + v[j][1] * w[1]) + (v[j][2] * w[2] + v[j][3] * w[3]); }
            a8[g] = wave_sum(s); }
        u32x2* o8 = (u32x2*)(XB + (size_t)row * 1024) + C.lane;
#pragma unroll
        for (int j = 0; j < 4; ++j) { u32x2 w; w.x = cvt_pk_bf16(v[j][0], v[j][1]); w.y = cvt_pk_bf16(v[j][2], v[j][3]); o8[64 * j] = w; }
        if (C.lane == 0) {
#pragma unroll
            for (int h = 0; h < 4; ++h) { IG[(size_t)row * 4 + h] = a8[h] + p.in[6][h]; LF[(size_t)row * 4 + h] = log_sigmoid(a8[4 + h] + p.in[7][h]); } }
    }
    bf16_t* WCAT = (bf16_t*)(ws + W_CAT); bf16_t* WG = (bf16_t*)(ws + W_G);
    constexpr int NITEMS = 6 * 512 + 3 * 128 + 3 * 512;
    for (int it = C.gw; it < NITEMS; it += C.ngw) { int r = it;
        TR(w_in + 0, INW, 1024, 1024, WCAT, 1.f)
        TR(w_in + 1024, INW, 1024, 1024, WCAT + 1024 * 1024, 1.f)
        TR(w_in + 3072, INW, 1024, 1024, WCAT + 2 * 1024 * 1024, 1.f)
        TR(w_in + 2048, INW, 1024, 1024, (bf16_t*)(ws + W_VT), 1.f)
        TR(w_in + 4104, INW, 1024, 1024, WG, 1.f)
        TR(w_in + 5128, INW, 1024, 1024, WG + 1024 * 1024, 1.f)
        TR4(p.in[9], (bf16_t*)(ws + W_PW), 1.f)
        TR4(p.in[4], (bf16_t*)(ws + W_Q), 1.f)
        TR4(p.in[5], (bf16_t*)(ws + W_K), 0.0625f)
        TR(p.in[11], 1024, 1024, 1024, (bf16_t*)(ws + W_PP), 1.f)
        TR(p.in[12], 1024, 1024, 1024, (bf16_t*)(ws + W_M), 1.f)
        TR(p.in[13], 1024, 1024, 1024, (bf16_t*)(ws + W_O), 1.f)
    }
}
__device__ __forceinline__ void late_weights(const Ctx& C, const Params& p) {
    LAS float* scr = (LAS float*)(C.lds + 32768 + C.wave * 8448);
    constexpr int NITEMS = 2 * 2048;
    for (int it = C.gw; it < NITEMS; it += C.ngw) { int r = it;
        TR(p.in[16], 4096, 1024, 4096, (bf16_t*)(p.ws + W_UP), 1.f)
        TR(p.in[17], 1024, 4096, 1024, (bf16_t*)(p.ws + W_DN), 1.f)
    }
}

__device__ __forceinline__ void phase2(const Ctx& C, const Params& p, const bf16_t* U, const bf16_t* XM, bf16_t* PL, bf16_t* XC) {
    unsigned char* ws = p.ws;
    if (C.gw < 16) {
        const float* IG = (const float*)(ws + S_IG); const float* LF = (const float*)(ws + S_LF);
        float* WS = (float*)(ws + S_WS); float* EB = (float*)(ws + S_EB); float* KAP = (float*)(ws + S_KAP);
        const int bh = C.gw, b_ = bh >> 2, h = bh & 3, lane = C.lane; float mst = 0.f;
        for (int c = 0; c < 16; ++c) {
            const int s0 = c * 256 + lane * 4; float lf[4], ig[4];
#pragma unroll
            for (int e = 0; e < 4; ++e) { const size_t t = (size_t)b_ * 4096 + s0 + e; lf[e] = LF[t * 4 + h]; ig[e] = IG[t * 4 + h]; }
            const float p0 = lf[0], p1 = p0 + lf[1], p2 = p1 + lf[2], p3 = p2 + lf[3];
            float incl = p3;
#pragma unroll
            for (int o = 1; o < 64; o <<= 1) { const float y = __shfl_up(incl, o); if (lane >= o) incl += y; }
            const float off = incl - p3, bl = __shfl(incl, 63);
            float bb[4] = {off + p0, off + p1, off + p2, off + p3}; float a[4]; float am = -3.0e38f;
#pragma unroll
            for (int e = 0; e < 4; ++e) { a[e] = ig[e] - bb[e]; am = fmaxf(am, a[e]); }
            am = wave_max(am);
            const float G = fmaxf(mst, am), kap = expf(mst - G);
            f32x4 w;
#pragma unroll
            for (int e = 0; e < 4; ++e) { w[e] = expf(a[e] - G); EB[((size_t)b_ * 4096 + s0 + e) * 4 + h] = expf(-(bb[e] + G)); }
            *(f32x4*)(WS + (size_t)bh * 4096 + s0) = w;
            if (lane == 0) KAP[bh * 16 + c] = kap;
            mst = bl + G;
        }
    }
    const float* conv_w = p.in[2]; const float* conv_b = p.in[3];
    for (int idx = C.gtid; idx < 1024 * 128; idx += C.ngt) {
        const int cb = idx & 127, r = idx >> 7, t0 = r * 16, s0 = t0 & 4095, c0 = cb * 8;
        {
            const int w = 2 << (cb >> 5); const bf16_t* up = U + (size_t)t0 * 1024 + c0; bf16_t* op = PL + (size_t)t0 * 1024 + c0;
            f32x4 sa = {0.f, 0.f, 0.f, 0.f}, sb = {0.f, 0.f, 0.f, 0.f};
            for (int k = 1; k <= w; ++k) if (s0 - k >= 0) { f32x4 a, b; unpack8(*(const u32x4*)(up - (size_t)k * 1024), a, b); sa = sa + a; sb = sb + b; }
            for (int i = 0; i < 16; ++i) { f32x4 ca, cbv; unpack8(*(const u32x4*)(up + (size_t)i * 1024), ca, cbv); sa = sa + ca; sb = sb + cbv; const int s = s0 + i;
                if (s >= w) { f32x4 a, b; unpack8(*(const u32x4*)(up + (size_t)(i - w) * 1024), a, b); sa = sa - a; sb = sb - b; }
                const float inv = 1.f / (float)((s + 1) < w ? (s + 1) : w);
                *(u32x4*)(op + (size_t)i * 1024) = pack8(sa * inv - ca, sb * inv - cbv); }
        }
        {
            const bf16_t* xp = XM + (size_t)t0 * 1024 + c0; bf16_t* op = XC + (size_t)t0 * 1024 + c0;
            f32x4 w0a = *(const f32x4*)(conv_w + c0), w0b = *(const f32x4*)(conv_w + c0 + 4), w1a = *(const f32x4*)(conv_w + 1024 + c0), w1b = *(const f32x4*)(conv_w + 1024 + c0 + 4);
            f32x4 w2a = *(const f32x4*)(conv_w + 2048 + c0), w2b = *(const f32x4*)(conv_w + 2048 + c0 + 4), w3a = *(const f32x4*)(conv_w + 3072 + c0), w3b = *(const f32x4*)(conv_w + 3072 + c0 + 4);
            const f32x4 ba = *(const f32x4*)(conv_b + c0), bbv = *(const f32x4*)(conv_b + c0 + 4);
            f32x4 x0a = {0.f, 0.f, 0.f, 0.f}, x0b = x0a, x1a = x0a, x1b = x0a, x2a = x0a, x2b = x0a;
            if (s0 > 0) { unpack8(*(const u32x4*)(xp - 3 * 1024), x0a, x0b); unpack8(*(const u32x4*)(xp - 2 * 1024), x1a, x1b); unpack8(*(const u32x4*)(xp - 1024), x2a, x2b); }
            for (int i = 0; i < 16; ++i) { f32x4 x3a, x3b; unpack8(*(const u32x4*)(xp + (size_t)i * 1024), x3a, x3b);
                f32x4 ya = w0a * x0a + w1a * x1a + w2a * x2a + w3a * x3a + ba, yb = w0b * x0b + w1b * x1b + w2b * x2b + w3b * x3b + bbv;
                *(u32x4*)(op + (size_t)i * 1024) = pack8(ya * sigm4(ya), yb * sigm4(yb));
                x0a = x1a; x0b = x1b; x1a = x2a; x1b = x2b; x2a = x3a; x2b = x3b; }
        }
    }
}

__device__ __forceinline__ void dn_partials(const Ctx& C, const bf16_t* KW, float* DNP) {
    for (int it = C.gw; it < 1024; it += C.ngw) { const int L = it >> 2, kg = it & 3, bh = L >> 4, ch = L & 15;
        const bf16_t* kp = KW + ((size_t)((bh >> 2) * 4096 + ch * 256)) * 1024 + (bh & 3) * 256 + kg * 64 + C.lane; float s = 0.f;
#pragma unroll 8
        for (int t = 0; t < 256; ++t) s += __uint_as_float((unsigned)kp[(size_t)t * 1024] << 16);
        DNP[L * 256 + kg * 64 + C.lane] = s; }
}
__device__ __forceinline__ void state_scan(const Ctx& C, float* DC, const float* DNP, float* DN, const float* KAP) {
    for (int r = C.gw; r < 4096; r += C.ngw) { const int bh = r >> 8, vd = r & 255; f32x4 Cst = {0.f, 0.f, 0.f, 0.f};
        for (int c = 0; c < 16; ++c) { const float kap = KAP[bh * 16 + c]; float* rowp = DC + ((size_t)(bh * 16 + c) * 256 + vd) * 256;
            const f32x4 d = *((const f32x4*)rowp + C.lane);
            asm volatile("s_waitcnt vmcnt(0)" ::: "memory");
            const f32x4 Dv = Cst * kap; u32x2 w; w.x = cvt_pk_bf16(Dv[0], Dv[1]); w.y = cvt_pk_bf16(Dv[2], Dv[3]);
            *((u32x2*)rowp + C.lane) = w;
            asm volatile("" ::: "memory");
            Cst = Dv + d; } }
    for (int idx = C.gtid; idx < 4096; idx += C.ngt) { const int bh = idx >> 8, kd = idx & 255; float n = 0.f;
        for (int c = 0; c < 16; ++c) { const float Dn = KAP[bh * 16 + c] * n; DN[(bh * 16 + c) * 256 + kd] = Dn; n = Dn + DNP[(bh * 16 + c) * 256 + kd]; } }
}
__device__ __forceinline__ void head_norm(const Ctx& C, const Params& p, bf16_t* OUTP, const bf16_t* Q, const bf16_t* P, const bf16_t* SO) {
    const float* DN = (const float*)(p.ws + S_DN); const float* EB = (const float*)(p.ws + S_EB); const float* hng = p.in[8];
    for (int r = C.gw; r < T * 4; r += C.ngw) { const int t = r >> 2, h = r & 3, b_ = t >> 12, s = t & 4095, ch = s >> 8, i = s & 255, L = (b_ * 4 + h) * 16 + ch;
        const size_t off = (size_t)t * 1024 + h * 256 + 4 * C.lane;
        const u32x2 o2 = *(const u32x2*)(OUTP + off), q2 = *(const u32x2*)(Q + off), s2 = *(const u32x2*)(SO + off), p2 = *(const u32x2*)(P + ((size_t)L * 256 + i) * 256 + 4 * C.lane);
        const f32x4 dn = *(const f32x4*)(DN + L * 256 + 4 * C.lane), g = *(const f32x4*)(hng + h * 256 + 4 * C.lane);
        float den = (bf_lo(q2.x) * dn[0] + bf_hi(q2.x) * dn[1]) + (bf_lo(q2.y) * dn[2] + bf_hi(q2.y) * dn[3]) + (bf_lo(p2.x) + bf_hi(p2.x)) + (bf_lo(p2.y) + bf_hi(p2.y));
        den = wave_sum(den);
        const float inv = 1.f / fmaxf(fabsf(den), EB[(size_t)t * 4 + h]);
        f32x4 hv = {bf_lo(o2.x) * inv, bf_hi(o2.x) * inv, bf_lo(o2.y) * inv, bf_hi(o2.y) * inv};
        const float mu = wave_sum((hv[0] + hv[1]) + (hv[2] + hv[3])) * (1.f / 256.f);
        hv = hv - mu;
        const float var = wave_sum((hv[0] * hv[0] + hv[1] * hv[1]) + (hv[2] * hv[2] + hv[3] * hv[3])) * (1.f / 256.f);
        const float rstd = 1.f / sqrtf(var + HN_EPS);
        const f32x4 so = {bf_lo(s2.x), bf_hi(s2.x), bf_lo(s2.y), bf_hi(s2.y)};
        const f32x4 y = hv * rstd * g * so; u32x2 w; w.x = cvt_pk_bf16(y[0], y[1]); w.y = cvt_pk_bf16(y[2], y[3]);
        *(u32x2*)(OUTP + off) = w; }
}
__device__ __forceinline__ void ln_rows(const Ctx& C, const float* in, float* out, bf16_t* outb, const float* g, const float* b) {
    f32x4 gv[4], bv[4];
#pragma unroll
    for (int j = 0; j < 4; ++j) { gv[j] = *((const f32x4*)g + C.lane + 64 * j); bv[j] = *((const f32x4*)b + C.lane + 64 * j); }
    for (int row = C.gw; row < T; row += C.ngw) { const f32x4* xr = (const f32x4*)(in + (size_t)row * 1024) + C.lane; f32x4 v[4]; float s = 0.f;
#pragma unroll
        for (int j = 0; j < 4; ++j) { v[j] = xr[64 * j]; s += (v[j][0] + v[j][1]) + (v[j][2] + v[j][3]); }
        const float mean = wave_sum(s) * (1.f / 1024.f); float s2 = 0.f;
#pragma unroll
        for (int j = 0; j < 4; ++j) { v[j] = v[j] - mean; s2 += (v[j][0] * v[j][0] + v[j][1] * v[j][1]) + (v[j][2] * v[j][2] + v[j][3] * v[j][3]); }
        const float rstd = 1.f / sqrtf(wave_sum(s2) * (1.f / 1024.f) + LN_EPS);
        f32x4* orow = (f32x4*)(out + (size_t)row * 1024) + C.lane;
#pragma unroll
        for (int j = 0; j < 4; ++j) { const f32x4 y = v[j] * rstd * gv[j] + bv[j]; orow[64 * j] = y;
            if (outb) { u32x2 w; w.x = cvt_pk_bf16(y[0], y[1]); w.y = cvt_pk_bf16(y[2], y[3]); *((u32x2*)(outb + (size_t)row * 1024) + C.lane + 64 * j) = w; } } }
}

#define GAS __attribute__((address_space(1)))
#define XB_TMO      128
#define XB_XCNT(j)  (256  + 64 * (j))
#define XB_XSUB(j)  (1280 + 64 * (j))
#define XB_XGEN(j)  (2304 + 64 * (j))
#define XB_TOP      3328
#define XB_TOPGEN   3392
#define XCD_BAR_WORDS 3456
#define XB_SPIN_CAP (1u << 18)

__device__ __forceinline__ unsigned xb_ld(unsigned* p)              { return __hip_atomic_load(p, __ATOMIC_RELAXED, __HIP_MEMORY_SCOPE_AGENT); }
__device__ __forceinline__ unsigned xb_add(unsigned* p, unsigned v) { return __hip_atomic_fetch_add(p, v, __ATOMIC_RELAXED, __HIP_MEMORY_SCOPE_AGENT); }
__device__ __forceinline__ unsigned xb_xcc_id() { return (unsigned)__builtin_amdgcn_s_getreg((3 << 11) | 20) & 0xFu; }
#define XB_SPIN(cond, bar) do { unsigned _sp = 0; while (cond) { __builtin_amdgcn_s_sleep(1); \
    if ((++_sp & 255u) == 0u) { if (xb_ld(&(bar)[XB_TMO])) break; if (_sp > XB_SPIN_CAP) { atomicAdd(&(bar)[XB_TMO], 1u); break; } } } } while (0)

struct XcdBarrier {
    unsigned* bar; unsigned x;
    volatile LAS unsigned* st;
};

__device__ __forceinline__ XcdBarrier xcd_barrier_post(unsigned* bar, volatile LAS unsigned* st) {
    XcdBarrier b; b.bar = bar; b.x = xb_xcc_id(); b.st = st;
    if (threadIdx.x == 0) (void)xb_add(&bar[XB_XCNT(b.x)], 1u);
    return b;
}
__device__ __forceinline__ void xcd_barrier_complete(unsigned* bar, unsigned x, unsigned& nloc, unsigned& nx) {
    const unsigned G = gridDim.x * gridDim.y * gridDim.z;
    unsigned sum, cnt, mine, sp = 0u;
    for (;;) {
        sum = 0u; cnt = 0u; mine = 0u;
#pragma unroll
        for (unsigned j = 0; j < 16; ++j) { const unsigned c = xb_ld(&bar[XB_XCNT(j)]); sum += c; cnt += (c > 0u) ? 1u : 0u; mine = (j == x) ? c : mine; }
        if (sum == G) break;
        __builtin_amdgcn_s_sleep(1);
        if ((++sp & 255u) == 0u) { if (xb_ld(&bar[XB_TMO])) break; if (sp > XB_SPIN_CAP) { atomicAdd(&bar[XB_TMO], 1u); break; } }
    }
    nloc = mine > 0u ? mine : 1u; nx = cnt > 0u ? cnt : 1u;
}

__device__ __forceinline__ void xcd_barrier(const XcdBarrier& b) {
    asm volatile("s_waitcnt vmcnt(0)" ::: "memory");
    __syncthreads();
    if (threadIdx.x == 0) {
        unsigned* bar = b.bar;
        __builtin_amdgcn_s_waitcnt(0);
        unsigned nloc = b.st[0], nx = b.st[1];
        if (nloc == 0u) { xcd_barrier_complete(bar, b.x, nloc, nx); b.st[0] = nloc; b.st[1] = nx; }
        const unsigned old = xb_add(&bar[XB_XSUB(b.x)], 1u);
        const unsigned gen = old / nloc;
        if (old + 1u == (gen + 1u) * nloc) {
            __builtin_amdgcn_fence(__ATOMIC_RELEASE, "agent");
            asm volatile("s_waitcnt vmcnt(0)" ::: "memory");
            const unsigned og = xb_add(&bar[XB_TOP], 1u);
            const unsigned tg = og / nx;
            if (og + 1u == (tg + 1u) * nx) xb_add(&bar[XB_TOPGEN], 1u);
            else XB_SPIN(xb_ld(&bar[XB_TOPGEN]) == tg, bar);
            __builtin_amdgcn_fence(__ATOMIC_ACQUIRE, "agent");
            xb_add(&bar[XB_XGEN(b.x)], 1u);
            asm volatile("s_waitcnt vmcnt(0)" ::: "memory");
        } else {
            XB_SPIN(xb_ld(&bar[XB_XGEN(b.x)]) == gen, bar);
            __builtin_amdgcn_fence(__ATOMIC_ACQUIRE, "agent");
            asm volatile("s_waitcnt vmcnt(0)" ::: "memory");
        }
    }
    __syncthreads();
}

constexpr int LDS_BYTES = 131072 + 256;
constexpr size_t S_BAR = 28 * MiB;
__global__ void __launch_bounds__(512, 2) hybrid_fwd(Params p) {
    extern __shared__ __attribute__((aligned(16))) unsigned char lds_raw[];
    cg::grid_group grid = cg::this_grid();
    typedef const __attribute__((address_space(4))) Params* KP;
    KP pp = (KP)__builtin_amdgcn_kernarg_segment_ptr();
#define MKCTX() Ctx C; C.lds = (LAS unsigned char*)lds_raw; C.tid = threadIdx.x; C.lane = C.tid & 63; C.wave = __builtin_amdgcn_readfirstlane(C.tid >> 6); \
    const int G = gridDim.x, bx = blockIdx.x; C.gw = bx * 8 + C.wave; C.ngw = G * 8; C.gtid = bx * 512 + C.tid; C.ngt = G * 512; (void)G; (void)bx
#define PH_BEGIN() asm volatile("" : "+s"(pp)); Params p; _Pragma("unroll") for (int _i = 0; _i < 20; ++_i) p.in[_i] = pp->in[_i]; p.out = pp->out; p.ws = pp->ws; MKCTX(); unsigned char* ws = p.ws; unsigned char* ob = (unsigned char*)p.out; const char* cws = (const char*)ws; (void)ob; (void)cws
#define GSYNC0() do { asm volatile("s_waitcnt vmcnt(0) lgkmcnt(0)" ::: "memory"); grid.sync(); } while (0)
#define GSYNC() do { asm volatile("s_waitcnt vmcnt(0) lgkmcnt(0)" ::: "memory"); xcd_barrier(xbar); } while (0)
#define SL(k) (ws + SLOT0 + (size_t)(k) * SLOT)
#define B_XB ((bf16_t*)SL(0))
#define B_U ((bf16_t*)SL(1))
#define B_XM ((bf16_t*)SL(2))
#define B_SO ((bf16_t*)SL(3))
#define B_VT ((bf16_t*)SL(4))
#define B_PL ((bf16_t*)SL(5))
#define B_XC ((bf16_t*)SL(6))
#define B_P2B ((bf16_t*)SL(1))
#define B_Q ((bf16_t*)SL(2))
#define B_KW ((bf16_t*)ob)
#define B_KT ((bf16_t*)(ob + SLOT))
#define B_DC ((float*)SL(5))
#define B_P ((bf16_t*)(ob + SLOT))
#define B_OUTP ((bf16_t*)ob)
#define B_PO ((bf16_t*)SL(2))
#define B_SGP ((bf16_t*)SL(3))
#define B_SGM ((bf16_t*)SL(4))
#define B_MG ((bf16_t*)SL(5))
#define B_Y (p.out)
#define B_X1 ((float*)SL(0))
#define B_X1B ((bf16_t*)SL(2))
#define B_HID ((bf16_t*)SL(3))

    if (threadIdx.x < 2) ((volatile LAS unsigned*)(lds_raw + 131072))[threadIdx.x] = 0u;
    { PH_BEGIN(); if (bx == 0) for (int k = C.tid; k < XCD_BAR_WORDS; k += 512) ((unsigned*)(ws + S_BAR))[k] = 0u; phase0(C, p); }
    GSYNC0();
    XcdBarrier xbar = xcd_barrier_post((unsigned*)(pp->ws + S_BAR), (volatile LAS unsigned*)(lds_raw + 131072));
    { PH_BEGIN(); SchedMN S{(const char*)B_XB, cws + W_CAT, 64, 12, 768, G, bx, (size_t)256 * 2048, 0, (size_t)256 * 2048, 0}; EpiSec<2> E{B_U, SLOT / 2};
      pg8::gemm_phase<EpiSec<2>, SchedMN>(C.lds, 1024, 1024, 1024, S, E); }
    { PH_BEGIN(); SchedMN S{cws + W_VT, (const char*)B_XB, 4, 64, 256, G, bx, (size_t)256 * 2048, 0, (size_t)256 * 2048, 0}; EpiT<0> E{B_VT, nullptr};
      pg8::gemm_phase<EpiT<0>, SchedMN>(C.lds, 1024, 1024, 1024, S, E); }
    GSYNC();
    { PH_BEGIN(); phase2(C, p, B_U, B_XM, B_PL, B_XC); }
    GSYNC();
    { PH_BEGIN(); SchedMN S{(const char*)B_PL, cws + W_PW, 64, 4, 256, G, bx, (size_t)256 * 2048, 512, (size_t)256 * 512, 0}; EpiScale<0> E{B_P2B, p.in[10]};
      pg8::gemm_phase<EpiScale<0>, SchedMN>(C.lds, 256, 1024, 256, S, E); }
    { PH_BEGIN(); SchedMN S{(const char*)B_XC, cws + W_Q, 64, 4, 256, G, bx, (size_t)256 * 2048, 512, (size_t)256 * 512, 0}; EpiSec<9> E{B_Q, 256};
      pg8::gemm_phase<EpiSec<9>, SchedMN>(C.lds, 256, 1024, 256, S, E); }
    { PH_BEGIN(); SchedMN S{(const char*)B_XC, cws + W_K, 64, 4, 256, G, bx, (size_t)256 * 2048, 512, (size_t)256 * 512, 0}; EpiScale<1> E{B_KW, (const float*)(ws + S_WS)};
      pg8::gemm_phase<EpiScale<1>, SchedMN>(C.lds, 256, 1024, 256, S, E); }
    { PH_BEGIN(); SchedMN S{cws + W_K, (const char*)B_XC, 4, 64, 256, G, bx, (size_t)256 * 512, 0, (size_t)256 * 2048, 512}; EpiT<1> E{B_KT, (const float*)(ws + S_WS)};
      pg8::gemm_phase<EpiT<1>, SchedMN>(C.lds, 256, 256, 1024, S, E); }
    GSYNC();
    { PH_BEGIN(); Sched4 S{(const char*)B_VT, (const char*)B_KT, G, bx}; Epi4 E{B_DC};
      pg8::gemm_phase<Epi4, Sched4>(C.lds, 256, 4096, 4096, S, E); }
    { PH_BEGIN(); dn_partials(C, B_KW, (float*)(ws + S_DNP)); }
    GSYNC();
    { PH_BEGIN(); Sched5 S{(const char*)B_Q, (const char*)B_KW, G, bx}; Epi5 E{B_P};
      pg8::gemm_phase<Epi5, Sched5>(C.lds, 256, 1024, 1024, S, E); }
    { PH_BEGIN(); state_scan(C, B_DC, (const float*)(ws + S_DNP), (float*)(ws + S_DN), (const float*)(ws + S_KAP)); }
    GSYNC();
    { PH_BEGIN(); Sched6<0> S{(const char*)B_Q, (const char*)B_DC, G, bx}; Epi6<0> E{B_OUTP};
      pg8::gemm_phase<Epi6<0>, Sched6<0>>(C.lds, 256, 1024, 512, S, E); }
    { PH_BEGIN(); Sched6<1> S{(const char*)B_P, (const char*)B_VT, G, bx}; Epi6<1> E{B_OUTP};
      pg8::gemm_phase<Epi6<1>, Sched6<1>>(C.lds, 256, 256, 4096, S, E); }
    GSYNC();
    { PH_BEGIN(); head_norm(C, p, B_OUTP, B_Q, B_P, B_SO); }
    GSYNC();
    { PH_BEGIN(); SchedMN S{(const char*)B_P2B, cws + W_PP, 64, 4, 256, G, bx, (size_t)256 * 2048, 0, (size_t)256 * 2048, 0}; EpiSec<9> E{B_PO, 256};
      pg8::gemm_phase<EpiSec<9>, SchedMN>(C.lds, 1024, 1024, 1024, S, E); }
    { PH_BEGIN(); SchedMN S{(const char*)B_XB, cws + W_G, 64, 8, 512, G, bx, (size_t)256 * 2048, 0, (size_t)256 * 2048, 0}; EpiSec<0> E{B_SGP, SLOT / 2};
      pg8::gemm_phase<EpiSec<0>, SchedMN>(C.lds, 1024, 1024, 1024, S, E); }
    GSYNC();
    { PH_BEGIN(); SchedMN S{(const char*)B_OUTP, cws + W_M, 64, 4, 256, G, bx, (size_t)256 * 2048, 0, (size_t)256 * 2048, 0}; Epi9 E{B_PO, B_SGP, B_SGM, B_MG};
      pg8::gemm_phase<Epi9, SchedMN>(C.lds, 1024, 1024, 1024, S, E); }
    GSYNC();
    { PH_BEGIN(); SchedMN S{(const char*)B_MG, cws + W_O, 64, 4, 256, G, bx, (size_t)256 * 2048, 0, (size_t)256 * 2048, 0}; EpiRes E{p.in[0], B_Y};
      pg8::gemm_phase<EpiRes, SchedMN>(C.lds, 1024, 1024, 1024, S, E); }
    GSYNC();
    { PH_BEGIN(); ln_rows(C, B_Y, B_X1, B_X1B, p.in[14], p.in[15]); late_weights(C, p); }
    GSYNC();
    { PH_BEGIN(); SchedMN S{(const char*)B_X1B, cws + W_UP, 64, 16, 1024, G, bx, (size_t)256 * 2048, 0, (size_t)256 * 2048, 0}; EpiUp E{B_HID};
      pg8::gemm_phase<EpiUp, SchedMN>(C.lds, 1024, 1024, 1024, S, E); }
    GSYNC();
    { PH_BEGIN(); SchedMN S{(const char*)B_HID, cws + W_DN, 64, 4, 256, G, bx, (size_t)256 * 8192, 0, (size_t)256 * 8192, 0}; EpiRes E{B_X1, B_Y};
      pg8::gemm_phase<EpiRes, SchedMN>(C.lds, 4096, 4096, 4096, S, E); }
    GSYNC();
    { PH_BEGIN(); ln_rows(C, B_Y, B_Y, nullptr, p.in[18], p.in[19]); }
}

extern "C" void kernel_launch(void* const* d_in, const int* in_sizes, int n_in, void* d_out, int out_size, void* d_ws, size_t ws_size, hipStream_t stream) {
    static int grid = 0;
    if (grid == 0) {
        if (n_in != 20 || in_sizes[0] != T * DM || out_size != T * DM || ws_size < WS_NEED) { fprintf(stderr, "kernel_launch: unexpected shapes (n_in %d, in0 %d, out %d, ws %zu)\n", n_in, n_in > 0 ? in_sizes[0] : -1, out_size, ws_size); grid = -1; return; }
        int dev = 0, cus = 0, per_cu = 0;
        hipGetDevice(&dev); hipDeviceGetAttribute(&cus, hipDeviceAttributeMultiprocessorCount, dev);
        hipFuncSetAttribute((const void*)hybrid_fwd, hipFuncAttributeMaxDynamicSharedMemorySize, LDS_BYTES);
        hipOccupancyMaxActiveBlocksPerMultiprocessor(&per_cu, (const void*)hybrid_fwd, 512, LDS_BYTES);
        if (per_cu < 1) per_cu = 1;
        grid = cus * 1;
        (void)hipGetLastError();
    }
    if (grid < 0) return;
    Params p{};
    for (int i = 0; i < 20; ++i) p.in[i] = (const float*)d_in[i];
    p.out = (float*)d_out; p.ws = (unsigned char*)d_ws;
    void* args[] = {&p};
    hipError_t e = hipLaunchCooperativeKernel((const void*)hybrid_fwd, dim3(grid), dim3(512), args, LDS_BYTES, stream);
    if (e != hipSuccess) fprintf(stderr, "cooperative launch failed: %s (grid %d)\n", hipGetErrorString(e), grid);
}
```
